# Optimizing an MI355X kernel written in HIP

```python
import math
import jax
import jax.numpy as jnp
from jax import lax
import numpy as np

D_MODEL = 1024
BATCH = 8
SEQ = 2048
DEPTH = 4

GRID_W = 64
CTX_LEN = 256
N_MOD = 6
SSM_WIDTH = 256
SSM_GROUP = 16
SSM_GROUPS = SSM_WIDTH // SSM_GROUP
SSM_STATE = 64
DT_MIN = 1e-3
DT_MAX = 1e-1
CONV_WIDTH = 256
CONV_K = 31
RET_HEADS = 4
RET_HEAD_DIM = 128
RET_WIDTH = RET_HEADS * RET_HEAD_DIM
RET_CHUNK = 128
ROPE_BASE = 10000.0
N_BRANCH = 3
IN_WIDTH = SSM_WIDTH + 2 * CONV_WIDTH + 4 * RET_WIDTH + N_BRANCH * D_MODEL
N_EXPERTS = 32
TOP_K = 4
EXPERT_FF = D_MODEL
SWIGLU_LIMIT = 7.0
SWIGLU_ALPHA = 1.702
MOE_BLOCK = 128
EPS = 1e-6

kernel_name = 'hybrid_s5_conformer_retention_moe_dit'


def _rms(x):
    xf = x.astype(jnp.float32)
    return xf * lax.rsqrt(jnp.mean(xf * xf, axis=-1, keepdims=True) + EPS)


def rms_norm(x, g):
    return (_rms(x) * g.astype(jnp.float32)).astype(x.dtype)


def layer_norm(x, g, b):
    xf = x.astype(jnp.float32)
    mu = jnp.mean(xf, axis=-1, keepdims=True)
    var = jnp.mean(jnp.square(xf - mu), axis=-1, keepdims=True)
    y = (xf - mu) * lax.rsqrt(var + EPS) * g.astype(jnp.float32) + b.astype(jnp.float32)
    return y.astype(x.dtype)


def modulate(h, shift, scale):
    return h * (1 + scale) + shift


def split_in_proj(z):
    widths = (SSM_WIDTH, 2 * CONV_WIDTH, RET_WIDTH, RET_WIDTH, RET_WIDTH, RET_WIDTH,
              D_MODEL, D_MODEL, D_MODEL)
    return jnp.split(z, np.cumsum(widths)[:-1].tolist(), axis=-1)


def _flip(t, rev):
    return jnp.flip(t, 1) if rev else t


def _linear_combine(e1, e2):
    a1, b1 = e1
    a2, b2 = e2
    return a2 * a1, a2 * b1 + b2


def s5_discretize(lam_re, lam_im, log_dt, b_re, b_im):
    lam = lax.complex(jnp.minimum(lam_re.astype(jnp.float32), -1e-4), lam_im.astype(jnp.float32))
    lam_dt = lam * jnp.exp(log_dt.astype(jnp.float32))[:, None]
    lam_bar = jnp.exp(lam_dt)
    b = lax.complex(b_re.astype(jnp.float32), b_im.astype(jnp.float32))
    b_bar = ((lam_bar - 1.0) / lam)[..., None] * b
    return lam_dt, lam_bar, b_bar


def s5_scan(ug, lam_bar, b_bar, rev):
    bu = jnp.einsum('blgm,gpm->blgp', ug.astype(jnp.complex64), b_bar)
    bu = _flip(bu, rev)
    _, s = lax.associative_scan(_linear_combine, (jnp.broadcast_to(lam_bar, bu.shape), bu), axis=1)
    return _flip(s, rev)


def s5_branch(uc, ul, lam_re, lam_im, log_dt, b_re, b_im, c_re, c_im, d_skip, w_glu, b_glu):
    bsz, n_ctx, _ = uc.shape
    n_lat = ul.shape[1]
    ucg = uc.astype(jnp.float32).reshape(bsz, n_ctx, SSM_GROUPS, SSM_GROUP)
    ulg = ul.astype(jnp.float32).reshape(bsz, n_lat, SSM_GROUPS, SSM_GROUP)
    d = d_skip.astype(jnp.float32).reshape(SSM_GROUPS, SSM_GROUP)
    yc = ucg * d
    yl = ulg * d
    for direction, rev in enumerate((False, True)):
        lam_dt, lam_bar, b_bar = s5_discretize(lam_re[direction], lam_im[direction], log_dt[direction],
                                              b_re[direction], b_im[direction])
        c_mat = lax.complex(c_re[direction].astype(jnp.float32), c_im[direction].astype(jnp.float32))
        s_c = s5_scan(ucg, lam_bar, b_bar, rev)
        s_c_last = s_c[:, 0] if rev else s_c[:, -1]
        steps = (jnp.arange(n_lat, 0, -1) if rev else jnp.arange(1, n_lat + 1)).astype(jnp.float32)
        carry = jnp.exp(lam_dt * steps[:, None, None]) * s_c_last[:, None]
        s_l = s5_scan(ulg, lam_bar, b_bar, rev) + carry
        yc = yc + jnp.einsum('blgp,gmp->blgm', s_c, c_mat).real
        yl = yl + jnp.einsum('blgp,gmp->blgm', s_l, c_mat).real

    def glu_out(y, like):
        y = jax.nn.gelu(y.reshape(y.shape[0], y.shape[1], SSM_WIDTH)).astype(like.dtype)
        a, g = jnp.split(y @ w_glu + b_glu, 2, axis=-1)
        return a * jax.nn.sigmoid(g)

    return glu_out(yc, uc), glu_out(yl, ul)


def conv_branch(v, w_dw, b_dw, ln_g, ln_b, w_pw, b_pw):
    a, g = jnp.split(v, 2, axis=-1)
    h = a * jax.nn.sigmoid(g)
    h = lax.conv_general_dilated(h, w_dw.astype(h.dtype), window_strides=(1,),
                                 padding=[(CONV_K // 2, CONV_K // 2)],
                                 dimension_numbers=('NWC', 'WIO', 'NWC'),
                                 feature_group_count=CONV_WIDTH) + b_dw
    h = layer_norm(h, ln_g, ln_b)
    return jax.nn.silu(h) @ w_pw + b_pw


def _rope_1d(t, pos):
    n = t.shape[-1] // 2
    inv_freq = ROPE_BASE ** (-jnp.arange(n, dtype=jnp.float32) / n)
    ang = pos.astype(jnp.float32)[:, None] * inv_freq
    cos = jnp.cos(ang)[None, :, None, :]
    sin = jnp.sin(ang)[None, :, None, :]
    t1, t2 = t[..., :n], t[..., n:]
    return jnp.concatenate([t1 * cos - t2 * sin, t1 * sin + t2 * cos], axis=-1)


def rope_2d(t, rows, cols):
    half = t.shape[-1] // 2
    return jnp.concatenate([_rope_1d(t[..., :half], rows), _rope_1d(t[..., half:], cols)], axis=-1)


def retention_chunkwise(q, k, v, log_g, s0):
    bsz, n_pos, n_h, dh = q.shape
    n_chunk = n_pos // RET_CHUNK
    qc = q.reshape(bsz, n_chunk, RET_CHUNK, n_h, dh)
    kc = k.reshape(bsz, n_chunk, RET_CHUNK, n_h, dh)
    vc = v.reshape(bsz, n_chunk, RET_CHUNK, n_h, dh)
    idx = jnp.arange(RET_CHUNK, dtype=jnp.float32)
    diff = idx[:, None] - idx[None, :]
    mask = jnp.where(diff >= 0, jnp.exp(log_g[:, None, None] * jnp.maximum(diff, 0.0)), 0.0)
    scores = jnp.einsum('bnihd,bnjhd->bnhij', qc, kc) * mask
    intra = jnp.einsum('bnhij,bnjhe->bnihe', scores, vc)
    zeta = jnp.exp(log_g[:, None] * (RET_CHUNK - 1 - idx))
    chunk_kv = jnp.einsum('bnjhd,hj,bnjhe->bnhde', kc, zeta, vc)
    g_chunk = jnp.exp(log_g * RET_CHUNK)[None, :, None, None]

    def step(s, kv):
        return g_chunk * s + kv, s

    s_final, s_prev = lax.scan(step, s0, jnp.moveaxis(chunk_kv, 1, 0))
    s_prev = jnp.moveaxis(s_prev, 0, 1)
    inter_decay = jnp.exp(log_g[:, None] * (idx + 1.0))
    inter = jnp.einsum('bnihd,hi,bnhde->bnihe', qc, inter_decay, s_prev)
    return (intra + inter).reshape(bsz, n_pos, n_h, dh), s_final


def retention_branch(qc, kc, vc, gc, ql, kl, vl, gl, rows, cols, log_g_fwd, log_g_bwd, w_o):
    def heads(t):
        return t.astype(jnp.float32).reshape(t.shape[0], t.shape[1], RET_HEADS, RET_HEAD_DIM)

    k_scale = RET_HEAD_DIM ** -0.5
    qc_, kc_, vc_ = heads(qc), heads(kc) * k_scale, heads(vc)
    ql_ = rope_2d(heads(ql), rows, cols)
    kl_ = rope_2d(heads(kl), rows, cols) * k_scale
    vl_ = heads(vl)
    s0 = jnp.zeros((qc.shape[0], RET_HEADS, RET_HEAD_DIM, RET_HEAD_DIM), jnp.float32)
    oc = jnp.zeros_like(vc_)
    ol = jnp.zeros_like(vl_)
    for log_g, rev in ((log_g_fwd, False), (log_g_bwd, True)):
        o_c, s_ctx = retention_chunkwise(_flip(qc_, rev), _flip(kc_, rev), _flip(vc_, rev), log_g, s0)
        o_l, _ = retention_chunkwise(_flip(ql_, rev), _flip(kl_, rev), _flip(vl_, rev), log_g, s_ctx)
        oc = oc + _flip(o_c, rev)
        ol = ol + _flip(o_l, rev)

    def out(o, g):
        o = _rms(o).reshape(o.shape[0], o.shape[1], RET_WIDTH).astype(g.dtype)
        return (o * jax.nn.silu(g)) @ w_o

    return out(oc, gc), out(ol, gl)


def token_mixer(hc, hl, rows, cols, log_g_fwd, log_g_bwd, w_in,
                lam_re, lam_im, log_dt, b_re, b_im, c_re, c_im, d_skip, w_glu, b_glu,
                w_dw, b_dw, ln_g, ln_b, w_pw, b_pw, w_o, w_out):
    uc, cvc, qc, kc, vc, gc, gsc, gcc, grc = split_in_proj(hc @ w_in)
    ul, cvl, ql, kl, vl, gl, gsl, gcl, grl = split_in_proj(hl @ w_in)
    ssm_c, ssm_l = s5_branch(uc, ul, lam_re, lam_im, log_dt, b_re, b_im, c_re, c_im, d_skip, w_glu, b_glu)
    conv_c = conv_branch(cvc, w_dw, b_dw, ln_g, ln_b, w_pw, b_pw)
    conv_l = conv_branch(cvl, w_dw, b_dw, ln_g, ln_b, w_pw, b_pw)
    ret_c, ret_l = retention_branch(qc, kc, vc, gc, ql, kl, vl, gl, rows, cols, log_g_fwd, log_g_bwd, w_o)

    def merge(ys, ycv, yr, gs, gcv, gr):
        return (jax.nn.sigmoid(gs) * ys + jax.nn.sigmoid(gcv) * ycv + jax.nn.sigmoid(gr) * yr) @ w_out

    return merge(ssm_c, conv_c, ret_c, gsc, gcc, grc), merge(ssm_l, conv_l, ret_l, gsl, gcl, grl)


def moe_ffn(h, w_router, b_router, w_gu, b_gu, w_down, b_down):
    n_tok, d_model = h.shape
    n_assign = n_tok * TOP_K
    n_blocks = (n_assign + N_EXPERTS * (MOE_BLOCK - 1)) // MOE_BLOCK
    logits = (h @ w_router + b_router).astype(jnp.float32)
    top_logit, top_idx = lax.top_k(logits, TOP_K)
    gates = jax.nn.softmax(top_logit, axis=-1).astype(h.dtype)
    flat_e = top_idx.reshape(-1)
    order = jnp.argsort(flat_e)
    sorted_e = flat_e[order]
    counts = jnp.bincount(flat_e, length=N_EXPERTS)
    blocks_per = (counts + MOE_BLOCK - 1) // MOE_BLOCK
    block_end = jnp.cumsum(blocks_per)
    padded_start = (block_end - blocks_per) * MOE_BLOCK
    start = jnp.cumsum(counts) - counts
    dest = padded_start[sorted_e] + jnp.arange(n_assign) - start[sorted_e]
    slot = jnp.zeros((n_assign,), jnp.int32).at[order].set(dest.astype(jnp.int32))
    rows = jnp.full((n_blocks * MOE_BLOCK,), n_tok, jnp.int32).at[slot].set(
        jnp.arange(n_assign, dtype=jnp.int32) // TOP_K)
    block_expert = jnp.minimum(jnp.searchsorted(block_end, jnp.arange(n_blocks), side='right'), N_EXPERTS - 1)
    h_pad = jnp.concatenate([h, jnp.zeros((1, d_model), h.dtype)], axis=0)
    xb = h_pad[rows].reshape(n_blocks, MOE_BLOCK, d_model)

    def expert_block(args):
        xblk, e = args
        gu = xblk @ w_gu[e] + b_gu[e]
        gate = jnp.minimum(gu[:, :EXPERT_FF], SWIGLU_LIMIT)
        up = jnp.clip(gu[:, EXPERT_FF:], -SWIGLU_LIMIT, SWIGLU_LIMIT)
        act = (up + 1) * gate * jax.nn.sigmoid(gate * SWIGLU_ALPHA)
        return act @ w_down[e] + b_down[e]

    yb = lax.map(expert_block, (xb, block_expert)).reshape(-1, d_model)
    y = yb[slot].reshape(n_tok, TOP_K, d_model)
    return jnp.einsum('tkd,tk->td', y, gates)


def setup_inputs(seed: int = 0) -> dict:
    key = jax.random.key(seed)
    ks = iter(jax.random.split(key, 40))
    f32 = jnp.float32

    def nrm(shape, scale):
        return jax.random.normal(next(ks), shape, f32) * scale

    def gain(shape):
        return 1.0 + nrm(shape, 0.01)

    G, P, M, E, F = SSM_GROUPS, SSM_STATE, SSM_GROUP, N_EXPERTS, EXPERT_FF
    d_in = D_MODEL ** -0.5
    return {
        'x': nrm((BATCH, SEQ, D_MODEL), 1.0),
        'c': nrm((BATCH, D_MODEL), 1.0),
        'ctx': nrm((BATCH, CTX_LEN, D_MODEL), 1.0),
        'c_ctx': nrm((D_MODEL,), 1.0),
        'ada_w': nrm((DEPTH, D_MODEL, N_MOD * D_MODEL), 0.5 * d_in),
        'ada_b': nrm((DEPTH, N_MOD * D_MODEL), 0.01),
        'norm1_g': gain((DEPTH, D_MODEL)),
        'w_in': nrm((DEPTH, D_MODEL, IN_WIDTH), d_in),
        'ssm_lam_re': -0.5 + nrm((DEPTH, 2, G, P), 0.01),
        'ssm_lam_im': jnp.pi * jnp.arange(P, dtype=f32) + nrm((DEPTH, 2, G, P), 0.01),
        'ssm_log_dt': jax.random.uniform(next(ks), (DEPTH, 2, G), f32, math.log(DT_MIN), math.log(DT_MAX)),
        'ssm_b_re': nrm((DEPTH, 2, G, P, M), (2 * M) ** -0.5),
        'ssm_b_im': nrm((DEPTH, 2, G, P, M), (2 * M) ** -0.5),
        'ssm_c_re': nrm((DEPTH, 2, G, M, P), P ** -0.5),
        'ssm_c_im': nrm((DEPTH, 2, G, M, P), P ** -0.5),
        'ssm_d': nrm((DEPTH, SSM_WIDTH), 1.0),
        'ssm_glu_w': nrm((DEPTH, SSM_WIDTH, 2 * D_MODEL), SSM_WIDTH ** -0.5),
        'ssm_glu_b': nrm((DEPTH, 2 * D_MODEL), 0.01),
        'conv_dw_w': nrm((DEPTH, CONV_K, 1, CONV_WIDTH), CONV_K ** -0.5),
        'conv_dw_b': nrm((DEPTH, CONV_WIDTH), 0.01),
        'conv_ln_g': gain((DEPTH, CONV_WIDTH)),
        'conv_ln_b': nrm((DEPTH, CONV_WIDTH), 0.01),
        'conv_pw_w': nrm((DEPTH, CONV_WIDTH, D_MODEL), CONV_WIDTH ** -0.5),
        'conv_pw_b': nrm((DEPTH, D_MODEL), 0.01),
        'ret_w_o': nrm((DEPTH, RET_WIDTH, D_MODEL), RET_WIDTH ** -0.5),
        'w_out': nrm((DEPTH, D_MODEL, D_MODEL), d_in),
        'norm2_g': gain((DEPTH, D_MODEL)),
        'router_w': nrm((DEPTH, D_MODEL, E), d_in),
        'router_b': nrm((DEPTH, E), 0.01),
        'exp_gu_w': nrm((DEPTH, E, D_MODEL, 2 * F), d_in),
        'exp_gu_b': nrm((DEPTH, E, 2 * F), 0.01),
        'exp_down_w': nrm((DEPTH, E, F, D_MODEL), F ** -0.5),
        'exp_down_b': nrm((DEPTH, E, D_MODEL), 0.01),
        'final_g': gain((D_MODEL,)),
    }


def reference(x, c, ctx, c_ctx, ada_w, ada_b, norm1_g, w_in, ssm_lam_re, ssm_lam_im, ssm_log_dt,
              ssm_b_re, ssm_b_im, ssm_c_re, ssm_c_im, ssm_d, ssm_glu_w, ssm_glu_b,
              conv_dw_w, conv_dw_b, conv_ln_g, conv_ln_b, conv_pw_w, conv_pw_b,
              ret_w_o, w_out, norm2_g, router_w, router_b, exp_gu_w, exp_gu_b,
              exp_down_w, exp_down_b, final_g):
    n_lat = x.shape[1]
    n_rows = n_lat // GRID_W
    rows = jnp.repeat(jnp.arange(n_rows, dtype=jnp.int32), GRID_W)
    cols = jnp.arange(n_lat, dtype=jnp.int32) % GRID_W
    log_g_fwd = jnp.log1p(-jnp.exp2(-5.0 - jnp.arange(RET_HEADS, dtype=jnp.float32)))
    log_g_bwd = log_g_fwd[::-1]
    s_lat = jax.nn.silu(c)
    s_ctx = jax.nn.silu(c_ctx)[None]
    xl, xc = x, ctx
    for i in range(DEPTH):
        last = i == DEPTH - 1
        mod_l = jnp.split((s_lat @ ada_w[i] + ada_b[i])[:, None, :], N_MOD, axis=-1)
        mod_c = jnp.split((s_ctx @ ada_w[i] + ada_b[i])[:, None, :], N_MOD, axis=-1)
        hc = modulate(rms_norm(xc, norm1_g[i]), mod_c[0], mod_c[1])
        hl = modulate(rms_norm(xl, norm1_g[i]), mod_l[0], mod_l[1])
        yc, yl = token_mixer(hc, hl, rows, cols, log_g_fwd, log_g_bwd, w_in[i],
                             ssm_lam_re[i], ssm_lam_im[i], ssm_log_dt[i], ssm_b_re[i], ssm_b_im[i],
                             ssm_c_re[i], ssm_c_im[i], ssm_d[i], ssm_glu_w[i], ssm_glu_b[i],
                             conv_dw_w[i], conv_dw_b[i], conv_ln_g[i], conv_ln_b[i], conv_pw_w[i], conv_pw_b[i],
                             ret_w_o[i], w_out[i])
        xl = xl + mod_l[2] * yl
        hl = modulate(rms_norm(xl, norm2_g[i]), mod_l[3], mod_l[4])
        moe_params = (router_w[i], router_b[i], exp_gu_w[i], exp_gu_b[i], exp_down_w[i], exp_down_b[i])
        if last:
            xl = xl + mod_l[5] * moe_ffn(hl.reshape(-1, D_MODEL), *moe_params).reshape(xl.shape)
        else:
            xc = xc + mod_c[2] * yc
            hc = modulate(rms_norm(xc, norm2_g[i]), mod_c[3], mod_c[4])
            n_ctx_tok = hc.shape[0] * hc.shape[1]
            y_all = moe_ffn(jnp.concatenate([hc.reshape(-1, D_MODEL), hl.reshape(-1, D_MODEL)], axis=0),
                            *moe_params)
            xc = xc + mod_c[5] * y_all[:n_ctx_tok].reshape(xc.shape)
            xl = xl + mod_l[5] * y_all[n_ctx_tok:].reshape(xl.shape)
    return rms_norm(xl, final_g)
```

```cpp
#include <hip/hip_runtime.h>
#include <cstdio>
#include <cstdint>

#ifndef DBG
#define DBG 0
#endif
namespace pg8 {
#define PG8_LAS __attribute__((address_space(3)))
typedef unsigned short bf16_t;
typedef short bf16x8 __attribute__((ext_vector_type(8)));
typedef float f32x4 __attribute__((ext_vector_type(4)));
typedef unsigned u32x4 __attribute__((ext_vector_type(4)));
constexpr int BM = 256, BK = 64, HALF = 128, HTB = HALF * BK * 2  , STAGE_BYTES = 8 * HTB, NXCD = 8, WGM = 8;

__host__ __device__ __forceinline__ int lds_byte(int r, int c) { const int st = (r >> 4) * 2 + (c >> 5), rr = r & 15, cc = c & 31, ob = rr * 64 + cc * 2; return st * 1024 + (ob ^ (((ob >> 9) & 1) << 5)); }
__host__ __device__ __forceinline__ void stage_rc(int b, int& R, int& C) { const int st = b / 1024, sb = b % 1024, swz = sb ^ (((sb >> 9) & 1) << 5); R = (st >> 1) * 16 + swz / 64; C = (st & 1) * 32 + (swz % 64) / 2; }
__host__ __device__ __forceinline__ int perm32(int rho) { const int n = rho >> 4, i = rho & 15; return 8 * (i >> 2) + 4 * n + (i & 3); }

struct Unit { int pm, pn; };
struct Gemm { const bf16_t* A; const bf16_t* Bt; int M, N, K; };

struct StaticOrder {
    int nM, nN, nwg, G, c;
    __host__ __device__ void init(int M, int N, int G_, int c_) { nM = M / BM; nN = N / BM; nwg = nM * nN; G = G_; c = c_; }
    __host__ __device__ bool next(int i, Unit& u) const {
        const long L = (long)i * G + c; if (L >= nwg) return false;
        int wgid = (int)L; { const int q = nwg / NXCD, r = nwg % NXCD, xcd = wgid % NXCD, off = wgid / NXCD; wgid = (xcd < r ? xcd * (q + 1) : r * (q + 1) + (xcd - r) * q) + off; }
        const int nig = WGM * nN, gid = wgid / nig, fm = gid * WGM, gsz = (nM - fm) < WGM ? (nM - fm) : WGM;
        u.pm = fm + ((wgid % nig) % gsz); u.pn = (wgid % nig) / gsz; return true;
    }
    __device__ __forceinline__ void a_ready(const Unit&) const {}
    __device__ __forceinline__ void done(const Unit&) const {}
};

template <class Epi, class Sched, bool ALIGN_EPI = false, bool SP2 = false>
__device__ __forceinline__ void gemm_phase(PG8_LAS unsigned char* lds, const Gemm g, const Sched& S, const Epi& E, const int tid) {
    const int wid = __builtin_amdgcn_readfirstlane(tid >> 6), lane = tid & 63, wr = wid >> 2, wc = wid & 3, fr = lane & 15, fq = lane >> 4;
    const int K = g.K, nt = K / BK;
    unsigned voffA[2], voffB[2];
#pragma unroll
    for (int i = 0; i < 2; ++i) { int R, C; stage_rc(tid * 16 + i * 8192, R, C); const int Rb = Epi::PERM ? ((R & ~31) + perm32(R & 31)) : R;
        voffA[i] = (unsigned)(R * K + C) * 2u; voffB[i] = (unsigned)(Rb * K + C) * 2u; }
    const size_t kstep = (size_t)(BK * 2);
    const size_t hstep = (size_t)HALF * K * 2;
    const size_t tstep = 2 * hstep;
    const unsigned ldsw = (unsigned)wid * 1024u;
    const int aoff = lds_byte(wr * 64 + fr, fq * 8), boff = lds_byte(wc * 32 + fr, fq * 8);
#define PG8_SA(b, h) (((b) * 2 + (h)) * HTB)
#define PG8_SB(b, h) ((4 + (b) * 2 + (h)) * HTB)
#define PG8_STAGE(bufoff, gbase, voff) do { _Pragma("unroll") for (int _i = 0; _i < 2; ++_i) \
        __builtin_amdgcn_global_load_lds((const unsigned*)((const char*)(gbase) + (voff)[_i]), (PG8_LAS unsigned*)(lds + (bufoff) + ldsw + _i * 8192), 16, 0, 0); } while (0)
#define PG8_LDA(dst, b, h) do { _Pragma("unroll") for (int m = 0; m < 4; ++m) _Pragma("unroll") for (int k = 0; k < 2; ++k) dst[m][k] = *(const PG8_LAS bf16x8*)(lds + PG8_SA(b, h) + aoff + m * 2048 + k * 1024); } while (0)
#define PG8_LDB(dst, b, h) do { _Pragma("unroll") for (int n = 0; n < 2; ++n) _Pragma("unroll") for (int k = 0; k < 2; ++k) dst[n][k] = *(const PG8_LAS bf16x8*)(lds + PG8_SB(b, h) + boff + n * 2048 + k * 1024); } while (0)
#define PG8_MMA(ai, bj, At, Bt) do { __builtin_amdgcn_s_setprio(1); _Pragma("unroll") for (int m = 0; m < 4; ++m) _Pragma("unroll") for (int n = 0; n < 2; ++n) _Pragma("unroll") for (int k = 0; k < 2; ++k) \
        acc[ai][bj][m][n] = __builtin_amdgcn_mfma_f32_16x16x32_bf16(Bt[n][k], At[m][k], acc[ai][bj][m][n], 0, 0, 0); __builtin_amdgcn_s_setprio(0); } while (0)
#define PG8_WAIT_V(n) asm volatile("s_waitcnt vmcnt(" #n ")" ::: "memory")
#define PG8_WAIT_L(n) asm volatile("s_waitcnt lgkmcnt(" #n ")" ::: "memory")
#define PG8_BAR __builtin_amdgcn_s_barrier()
#define PG8_SCHED __builtin_amdgcn_sched_barrier(0)
    Unit cur, nxt; int ui = 0;
    if (!S.next(0, cur)) return;
    f32x4 acc[2][2][4][2];
#pragma unroll
    for (int a = 0; a < 2; ++a)
#pragma unroll
        for (int b = 0; b < 2; ++b)
#pragma unroll
            for (int m = 0; m < 4; ++m)
#pragma unroll
                for (int n = 0; n < 2; ++n) acc[a][b][m][n] = (f32x4){0.f, 0.f, 0.f, 0.f};
    bf16x8 At[4][2], B0[2][2], B1[2][2];
    const char* cA = (const char*)g.A + (size_t)cur.pm * tstep; const char* cB = (const char*)g.Bt + (size_t)cur.pn * tstep;
    S.a_ready(cur);
    if constexpr (SP2) {
        PG8_STAGE(PG8_SB(0, 0), cB, voffB); PG8_STAGE(PG8_SB(0, 1), cB + hstep, voffB); PG8_STAGE(PG8_SA(0, 0), cA, voffA); PG8_STAGE(PG8_SA(0, 1), cA + hstep, voffA);
        if (wr == 1) PG8_BAR;
        PG8_WAIT_V(2); PG8_BAR;
        PG8_STAGE(PG8_SB(1, 0), cB + kstep, voffB); PG8_STAGE(PG8_SA(1, 0), cA + kstep, voffA); PG8_STAGE(PG8_SB(1, 1), cB + hstep + kstep, voffB);
        PG8_WAIT_V(6); PG8_BAR;
    } else {
        PG8_STAGE(PG8_SB(0, 0), cB, voffB); PG8_STAGE(PG8_SA(0, 0), cA, voffA); PG8_STAGE(PG8_SB(0, 1), cB + hstep, voffB); PG8_STAGE(PG8_SA(0, 1), cA + hstep, voffA);
        if (wr == 1) PG8_BAR;
        PG8_WAIT_V(4); PG8_BAR;
        PG8_STAGE(PG8_SB(1, 0), cB + kstep, voffB); PG8_STAGE(PG8_SA(1, 0), cA + kstep, voffA); PG8_STAGE(PG8_SB(1, 1), cB + hstep + kstep, voffB);
        PG8_WAIT_V(6); PG8_BAR;
    }
    for (;;) {
        const bool has_next = S.next(ui + 1, nxt);
        const char* nA = has_next ? (const char*)g.A + (size_t)nxt.pm * tstep : cA; const char* nB = has_next ? (const char*)g.Bt + (size_t)nxt.pn * tstep : cB;
        for (int t = 0; t < nt; t += 2) {
            const bool last = (t == nt - 2);
            const char* a1 = cA + (size_t)(t + 1) * kstep;
            const char* a2 = last ? nA : cA + (size_t)(t + 2) * kstep; const char* b2 = last ? nB : cB + (size_t)(t + 2) * kstep;
            const char* a3 = a2 + kstep; const char* b3 = b2 + kstep;
            if (last && has_next) S.a_ready(nxt);
            if constexpr (SP2) {
            PG8_LDB(B0, 0, 0); PG8_LDB(B1, 0, 1); PG8_SCHED; PG8_LDA(At, 0, 0); PG8_STAGE(PG8_SA(1, 1), a1 + hstep, voffA);
            PG8_WAIT_V(8); PG8_WAIT_L(0); PG8_BAR; PG8_MMA(0, 0, At, B0); PG8_MMA(0, 1, At, B1); PG8_BAR; PG8_SCHED;
            PG8_LDA(At, 0, 1); PG8_STAGE(PG8_SB(0, 0), b2, voffB); PG8_STAGE(PG8_SB(0, 1), b2 + hstep, voffB); PG8_STAGE(PG8_SA(0, 0), a2, voffA);
            PG8_WAIT_V(8); PG8_WAIT_L(0); PG8_BAR; PG8_MMA(1, 0, At, B0); PG8_MMA(1, 1, At, B1); PG8_BAR; PG8_SCHED;
            PG8_LDB(B0, 1, 0); PG8_LDB(B1, 1, 1); PG8_SCHED; PG8_LDA(At, 1, 0); PG8_STAGE(PG8_SA(0, 1), a2 + hstep, voffA);
            PG8_WAIT_V(8); PG8_WAIT_L(0); PG8_BAR; PG8_MMA(0, 0, At, B0); PG8_MMA(0, 1, At, B1); PG8_BAR; PG8_SCHED;
            PG8_LDA(At, 1, 1); PG8_STAGE(PG8_SB(1, 0), b3, voffB); PG8_STAGE(PG8_SB(1, 1), b3 + hstep, voffB); PG8_STAGE(PG8_SA(1, 0), a3, voffA);
            PG8_WAIT_V(8); PG8_WAIT_L(0); PG8_BAR; PG8_MMA(1, 0, At, B0); PG8_MMA(1, 1, At, B1); PG8_BAR; PG8_SCHED;
            } else {
            PG8_LDB(B0, 0, 0); PG8_SCHED; PG8_LDA(At, 0, 0); PG8_STAGE(PG8_SA(1, 1), a1 + hstep, voffA);
            PG8_WAIT_L(8); PG8_BAR; PG8_WAIT_L(0); PG8_MMA(0, 0, At, B0); PG8_BAR; PG8_SCHED;
            PG8_LDB(B1, 0, 1); PG8_STAGE(PG8_SB(0, 0), b2, voffB);
            PG8_BAR; PG8_WAIT_L(0); PG8_MMA(0, 1, At, B1); PG8_BAR;
            PG8_LDA(At, 0, 1); PG8_STAGE(PG8_SA(0, 0), a2, voffA);
            PG8_BAR; PG8_WAIT_L(0); PG8_MMA(1, 0, At, B0); PG8_BAR; PG8_SCHED;
            PG8_STAGE(PG8_SB(0, 1), b2 + hstep, voffB);
            PG8_WAIT_V(6); PG8_BAR; PG8_MMA(1, 1, At, B1); PG8_BAR;
            PG8_LDB(B0, 1, 0); PG8_SCHED; PG8_LDA(At, 1, 0); PG8_STAGE(PG8_SA(0, 1), a2 + hstep, voffA);
            PG8_WAIT_L(8); PG8_BAR; PG8_WAIT_L(0); PG8_MMA(0, 0, At, B0); PG8_BAR; PG8_SCHED;
            PG8_LDB(B1, 1, 1); PG8_STAGE(PG8_SB(1, 0), b3, voffB);
            PG8_BAR; PG8_WAIT_L(0); PG8_MMA(0, 1, At, B1); PG8_BAR;
            PG8_LDA(At, 1, 1); PG8_STAGE(PG8_SA(1, 0), a3, voffA);
            PG8_BAR; PG8_WAIT_L(0); PG8_MMA(1, 0, At, B0); PG8_BAR; PG8_SCHED;
            PG8_STAGE(PG8_SB(1, 1), b3 + hstep, voffB);
            PG8_WAIT_V(6); PG8_BAR; PG8_MMA(1, 1, At, B1); PG8_BAR;
            }
        }
        if constexpr (ALIGN_EPI) { if (wr == 0) PG8_BAR; }
        if constexpr (!Epi::AFTER_DRAIN) { E(acc, cur, wr, wc, fr, fq); S.done(cur); }
        if (!has_next) break;
#pragma unroll
        for (int a = 0; a < 2; ++a)
#pragma unroll
            for (int b = 0; b < 2; ++b)
#pragma unroll
                for (int m = 0; m < 4; ++m)
#pragma unroll
                    for (int n = 0; n < 2; ++n) acc[a][b][m][n] = (f32x4){0.f, 0.f, 0.f, 0.f};
        cur = nxt; cA = nA; cB = nB; ++ui;
        if constexpr (ALIGN_EPI) { if (wr == 1) PG8_BAR; }
    }
    PG8_WAIT_V(0);
    if constexpr (!ALIGN_EPI) { if (wr == 0) PG8_BAR; }
    PG8_BAR;
    if constexpr (Epi::AFTER_DRAIN) { E.fused(acc, cur, wr, wc, fr, fq, lds, wid, lane); S.done(cur); }
#undef PG8_SA
#undef PG8_SB
#undef PG8_STAGE
#undef PG8_LDA
#undef PG8_LDB
#undef PG8_MMA
#undef PG8_WAIT_V
#undef PG8_WAIT_L
#undef PG8_BAR
#undef PG8_SCHED
}
}

#define XB_TMO      128
#define XB_XCNT(j)  (256  + 64 * (j))
#define XB_XSUB(j)  (1280 + 64 * (j))
#define XB_XGEN(j)  (2304 + 64 * (j))
#define XB_TOP      3328
#define XB_TOPGEN   3392
#define XCD_BAR_WORDS 3456
#define XB_SPIN_CAP (1u << 18)
#define LAS __attribute__((address_space(3)))

__device__ __forceinline__ unsigned xb_ld(unsigned* p)              { return __hip_atomic_load(p, __ATOMIC_RELAXED, __HIP_MEMORY_SCOPE_AGENT); }
__device__ __forceinline__ unsigned xb_add(unsigned* p, unsigned v) { return __hip_atomic_fetch_add(p, v, __ATOMIC_RELAXED, __HIP_MEMORY_SCOPE_AGENT); }
__device__ __forceinline__ unsigned xb_xcc_id() { return (unsigned)__builtin_amdgcn_s_getreg((3 << 11) | 20) & 0xFu; }
#define XB_SPIN(cond, bar) do { unsigned _sp = 0; while (cond) { __builtin_amdgcn_s_sleep(1); \
    if ((++_sp & 255u) == 0u) { if (xb_ld(&(bar)[XB_TMO])) break; if (_sp > XB_SPIN_CAP) { atomicAdd(&(bar)[XB_TMO], 1u); break; } } } } while (0)

struct XcdBarrier {
    unsigned* bar; unsigned x;
    volatile LAS unsigned* st;
};

__device__ __forceinline__ XcdBarrier xcd_barrier_post(unsigned* bar, volatile LAS unsigned* st) {
    XcdBarrier b; b.bar = bar; b.x = xb_xcc_id(); b.st = st;
    if (threadIdx.x == 0) (void)xb_add(&bar[XB_XCNT(b.x)], 1u);
    return b;
}
__device__ __forceinline__ void xcd_barrier_complete(unsigned* bar, unsigned x, unsigned& nloc, unsigned& nx) {
    const unsigned G = gridDim.x * gridDim.y * gridDim.z;
    unsigned sum, cnt, mine, sp = 0u;
    for (;;) {
        sum = 0u; cnt = 0u; mine = 0u;
#pragma unroll
        for (unsigned j = 0; j < 16; ++j) { const unsigned c = xb_ld(&bar[XB_XCNT(j)]); sum += c; cnt += (c > 0u) ? 1u : 0u; mine = (j == x) ? c : mine; }
        if (sum == G) break;
        __builtin_amdgcn_s_sleep(1);
        if ((++sp & 255u) == 0u) { if (xb_ld(&bar[XB_TMO])) break; if (sp > XB_SPIN_CAP) { atomicAdd(&bar[XB_TMO], 1u); break; } }
    }
    nloc = mine > 0u ? mine : 1u; nx = cnt > 0u ? cnt : 1u;
}

__device__ __forceinline__ void xcd_barrier(const XcdBarrier& b) {
    asm volatile("s_waitcnt vmcnt(0)" ::: "memory");
    __syncthreads();
    if (threadIdx.x == 0) {
        unsigned* bar = b.bar;
        __builtin_amdgcn_s_waitcnt(0);
        unsigned nloc = b.st[0], nx = b.st[1];
        if (nloc == 0u) { xcd_barrier_complete(bar, b.x, nloc, nx); b.st[0] = nloc; b.st[1] = nx; }
        const unsigned old = xb_add(&bar[XB_XSUB(b.x)], 1u);
        const unsigned gen = old / nloc;
        if (old + 1u == (gen + 1u) * nloc) {
            __builtin_amdgcn_fence(__ATOMIC_RELEASE, "agent");
            asm volatile("s_waitcnt vmcnt(0)" ::: "memory");
            const unsigned og = xb_add(&bar[XB_TOP], 1u);
            const unsigned tg = og / nx;
            if (og + 1u == (tg + 1u) * nx) xb_add(&bar[XB_TOPGEN], 1u);
            else XB_SPIN(xb_ld(&bar[XB_TOPGEN]) == tg, bar);
            __builtin_amdgcn_fence(__ATOMIC_ACQUIRE, "agent");
            xb_add(&bar[XB_XGEN(b.x)], 1u);
            asm volatile("s_waitcnt vmcnt(0)" ::: "memory");
        } else {
            XB_SPIN(xb_ld(&bar[XB_XGEN(b.x)]) == gen, bar);
            __builtin_amdgcn_fence(__ATOMIC_ACQUIRE, "agent");
            asm volatile("s_waitcnt vmcnt(0)" ::: "memory");
        }
    }
    __syncthreads();
}


#define GAS __attribute__((address_space(1)))
typedef unsigned short bf16;
typedef unsigned v4u __attribute__((ext_vector_type(4)));
typedef unsigned v2u __attribute__((ext_vector_type(2)));
typedef float f32x4 __attribute__((ext_vector_type(4)));
typedef float f32x2 __attribute__((ext_vector_type(2)));
typedef short bf16x8 __attribute__((ext_vector_type(8)));

constexpr int D = 1024, NB = 8, LAT = 2048, CTXL = 256, DEPTH = 4, SEQC = LAT + CTXL;
constexpr int T = NB * SEQC, TCTX = NB * CTXL;
constexpr int INW = 5888;
constexpr int ZU = 0, ZCA = 256, ZCG = 512, ZQ = 768, ZK = 1280, ZV = 1792, ZG = 2304, ZGS = 2816, ZGC = 3840, ZGR = 4864;
constexpr int NE = 32;
constexpr int XB_TILES = 328, XB_ROWS = XB_TILES * 256;
constexpr int NCH = 72;
constexpr int SROWS = NB * NCH;
constexpr int NWAVES = 8, NTHR = 512;
constexpr float EPS = 1e-6f;

constexpr size_t al4k(size_t x) { return (x + 4095) & ~(size_t)4095; }
constexpr size_t WS_CTL = 0, CTL_BYTES = 1u << 20;
constexpr size_t WS_MOD = WS_CTL + CTL_BYTES,        SZ_MOD = al4k((size_t)DEPTH * 9 * 6144 * 4);
constexpr size_t WS_LAMC = WS_MOD + SZ_MOD,          SZ_LAMC = al4k((size_t)DEPTH * 2 * 16 * 64 * 2 * 4);
constexpr size_t WS_WIN = WS_LAMC + SZ_LAMC,         SZ_WIN = al4k((size_t)DEPTH * INW * D * 2);
constexpr size_t WS_WGLU = WS_WIN + SZ_WIN,          SZ_WGLU = al4k((size_t)DEPTH * 2048 * 256 * 2);
constexpr size_t WS_WPW = WS_WGLU + SZ_WGLU,         SZ_WPW = al4k((size_t)DEPTH * 1024 * 256 * 2);
constexpr size_t WS_WO = WS_WPW + SZ_WPW,            SZ_WO = al4k((size_t)DEPTH * 1024 * 512 * 2);
constexpr size_t WS_WOUT = WS_WO + SZ_WO,            SZ_WOUT = al4k((size_t)DEPTH * 1024 * 1024 * 2);
constexpr size_t WS_WGU = WS_WOUT + SZ_WOUT,         SZ_WGU = al4k((size_t)DEPTH * NE * 2048 * 1024 * 2);
constexpr size_t WS_WD = WS_WGU + SZ_WGU,            SZ_WD = al4k((size_t)DEPTH * NE * 1024 * 1024 * 2);
constexpr size_t WS_SW1 = WS_WD + SZ_WD,             SZ_SW1 = al4k((size_t)DEPTH * 16 * 768 * 512 * 2);
constexpr size_t WS_SW2 = WS_SW1 + SZ_SW1,           SZ_SW2 = al4k((size_t)DEPTH * 16 * 512 * 256 * 2);
constexpr size_t WS_X = WS_SW2 + SZ_SW2,             SZ_X = al4k((size_t)T * D * 4);
constexpr size_t WS_H = WS_X + SZ_X,                 SZ_H = al4k((size_t)T * D * 2);
constexpr size_t WS_Z = WS_H + SZ_H,                 SZ_Z = al4k((size_t)T * INW * 2);
constexpr size_t WS_UG = WS_Z + SZ_Z,                SZ_UG = al4k((size_t)T * 256 * 2);
constexpr size_t SZ_HD = al4k((size_t)T * 512 * 2);
constexpr size_t WS_QR = WS_UG + SZ_UG, WS_KR = WS_QR + SZ_HD, WS_KTF = WS_KR + SZ_HD, WS_KTB = WS_KTF + SZ_HD, WS_VT = WS_KTB + SZ_HD;
constexpr size_t WS_CACT = WS_VT + SZ_HD,            SZ_CACT = al4k((size_t)T * 256 * 2);
constexpr size_t WS_Y1 = WS_CACT + SZ_CACT,          SZ_Y1 = al4k((size_t)16 * SROWS * 512 * 4);
constexpr size_t WS_ZC = WS_Y1 + SZ_Y1,              SZ_ZC = al4k((size_t)16 * SROWS * 256 * 4);
constexpr size_t WS_SIN = WS_ZC + SZ_ZC,             SZ_SIN = al4k((size_t)16 * SROWS * 256 * 2);
constexpr size_t WS_SPREV = WS_SIN + SZ_SIN,         SZ_SPREV = al4k((size_t)NB * 4 * 2 * 18 * 128 * 128 * 2);
constexpr size_t WS_SACT = WS_SPREV + SZ_SPREV,      SZ_SACT = al4k((size_t)T * 256 * 2);
constexpr size_t WS_RACT = WS_SACT + SZ_SACT,        SZ_RACT = al4k((size_t)T * 512 * 2);
constexpr size_t WS_M1 = WS_RACT + SZ_RACT,          SZ_M = al4k((size_t)T * D * 2);
constexpr size_t WS_M2 = WS_M1 + SZ_M;
constexpr size_t WS_XB = WS_M2 + SZ_M,               SZ_XB = al4k((size_t)XB_ROWS * D * 2);
constexpr size_t WS_ACT = WS_XB + SZ_XB, WS_YB = WS_ACT + SZ_XB;
constexpr size_t WS_AINFO = WS_YB + SZ_XB,           SZ_AI = al4k((size_t)T * 4 * 4);
constexpr size_t WS_AGATE = WS_AINFO + SZ_AI, WS_ASLOT = WS_AGATE + SZ_AI;
constexpr size_t WS_END = WS_ASLOT + SZ_AI;

constexpr int CW_BAR = 4096;
constexpr int CW_MOE = 16384;
constexpr int CW_HIST = 32768;
constexpr int CW_DBG = 65536;

constexpr int LDS_BYTES = 155648;
constexpr int MISC_OFF = LDS_BYTES - 256;

#define LDS_WAIT() asm volatile("s_waitcnt lgkmcnt(0)" ::: "memory")
#define VM_WAIT() asm volatile("s_waitcnt vmcnt(0)" ::: "memory")

__device__ __forceinline__ float bf2f(unsigned v) { return __uint_as_float(v << 16); }
__device__ __forceinline__ unsigned f2bf(float f) { unsigned u = __float_as_uint(f); return (u + 0x7fffu + ((u >> 16) & 1u)) >> 16; }
__device__ __forceinline__ unsigned pk2(float lo, float hi) { return f2bf(lo) | (f2bf(hi) << 16); }
__device__ __forceinline__ float blo(unsigned w) { return __uint_as_float(w << 16); }
__device__ __forceinline__ float bhi(unsigned w) { return __uint_as_float(w & 0xffff0000u); }
__device__ __forceinline__ float sigm(float x) { return 1.f / (1.f + __expf(-x)); }
__device__ __forceinline__ float silu_(float x) { return x / (1.f + __expf(-x)); }
__device__ __forceinline__ float gelu_tanh(float x) { const float z = 0.7978845608f * (x + 0.044715f * x * x * x); const float e = __expf(2.f * z); const float th = 1.f - 2.f / (e + 1.f); return 0.5f * x * (1.f + th); }
__device__ __forceinline__ float wave_sum(float v) {
#pragma unroll
    for (int o = 1; o < 64; o <<= 1) v += __shfl_xor(v, o);
    return v;
}
__device__ __forceinline__ void unpack8(const v4u w, float (&f)[8]) { f[0] = blo(w.x); f[1] = bhi(w.x); f[2] = blo(w.y); f[3] = bhi(w.y); f[4] = blo(w.z); f[5] = bhi(w.z); f[6] = blo(w.w); f[7] = bhi(w.w); }
__device__ __forceinline__ v4u pack8(const float (&f)[8]) { v4u w; w.x = pk2(f[0], f[1]); w.y = pk2(f[2], f[3]); w.z = pk2(f[4], f[5]); w.w = pk2(f[6], f[7]); return w; }
__device__ __forceinline__ int tokrow(int b, int n) { return n < CTXL ? b * CTXL + n : TCTX + b * LAT + (n - CTXL); }
__device__ __forceinline__ int modrow(int row) { return row < TCTX ? 8 : (row - TCTX) >> 11; }
__device__ __forceinline__ float lg2gamma(int hh) { return log1pf(-exp2f(-5.f - (float)hh)) * 1.4426950408889634f; }

template <int ROWS, int KC> __device__ __forceinline__ void bg_stage(LAS unsigned char* dst, const bf16* src, size_t ld, int tid) {
    constexpr int CPR = KC / 8, LSTR = KC * 2 + 16, N = ROWS * CPR / NTHR;
    static_assert(ROWS * CPR % NTHR == 0, "bg_stage");
    v4u v[N];
#pragma unroll
    for (int q = 0; q < N; ++q) { const int i = tid + q * NTHR, r = i / CPR, c = i % CPR; v[q] = *(const GAS v4u*)(src + (size_t)r * ld + c * 8); }
#pragma unroll
    for (int q = 0; q < N; ++q) { const int i = tid + q * NTHR, r = i / CPR, c = i % CPR; *(LAS v4u*)(dst + r * LSTR + c * 16) = v[q]; }
}
template <int NT, int KC> __device__ __forceinline__ void bg_mma(f32x4 (&acc)[NT], const LAS unsigned char* As, const LAS unsigned char* Bs, int arow0, int bcol0, int fr, int fq) {
    constexpr int LSTR = KC * 2 + 16;
    const LAS unsigned char* ap = As + (arow0 + fr) * LSTR + fq * 16;
    const LAS unsigned char* bp = Bs + (bcol0 + fr) * LSTR + fq * 16;
#pragma unroll
    for (int ks = 0; ks < KC / 32; ++ks) {
        const bf16x8 a = *(const LAS bf16x8*)(ap + ks * 64);
#pragma unroll
        for (int t = 0; t < NT; ++t) { const bf16x8 b = *(const LAS bf16x8*)(bp + t * 16 * LSTR + ks * 64); acc[t] = __builtin_amdgcn_mfma_f32_16x16x32_bf16(a, b, acc[t], 0, 0, 0); }
    }
}

struct Args { const float* in[34]; float* out; unsigned char* ws; };
enum { I_X = 0, I_C, I_CTX, I_CCTX, I_ADAW, I_ADAB, I_N1G, I_WIN, I_LRE, I_LIM, I_LDT, I_BRE, I_BIM, I_CRE, I_CIM, I_SD, I_GLUW, I_GLUB, I_DWW, I_DWB, I_LNG, I_LNB, I_PWW, I_PWB,
       I_WO, I_WOUT, I_N2G, I_RW, I_RB, I_GUW, I_GUB, I_DW, I_DB, I_FG };

__device__ __forceinline__ void transpose_item(const float* W, int K, int N, bf16* WT, int n0, int drow0, int k0, LAS float* scr, int lane) {
#pragma unroll 8
    for (int i = 0; i < 32; ++i) { const int kk = 2 * i + (lane >> 5); scr[kk * 33 + (lane & 31)] = W[(size_t)(k0 + kk) * N + n0 + (lane & 31)]; }
    LDS_WAIT(); asm volatile("" ::: "memory");
    const int c = lane & 7;
#pragma unroll
    for (int j = 0; j < 4; ++j) { const int n = (lane >> 3) + 8 * j; const LAS float* s = scr + (8 * c) * 33 + n;
        v4u o; o.x = pk2(s[0 * 33], s[1 * 33]); o.y = pk2(s[2 * 33], s[3 * 33]); o.z = pk2(s[4 * 33], s[5 * 33]); o.w = pk2(s[6 * 33], s[7 * 33]);
        *(GAS v4u*)(WT + (size_t)(drow0 + n) * K + k0 + 8 * c) = o; }
    LDS_WAIT(); asm volatile("" ::: "memory");
}
__device__ __forceinline__ int ilv128(int n0, int half) { const int q = n0 < half ? n0 : n0 - half; return (q >> 7) * 256 + (n0 < half ? 0 : 128) + (q & 127); }

constexpr int CV_WIN = 16 * 184, CV_GLU = 4 * 64, CV_PW = 4 * 32, CV_WO = 8 * 32, CV_WOUT = 16 * 32, CV_GU = NE * 16 * 64, CV_DN = NE * 16 * 32;
constexpr int CV_LAYER = CV_WIN + CV_GLU + CV_PW + CV_WO + CV_WOUT + CV_GU + CV_DN;

__device__ __forceinline__ void convert_item(const Args& a, int it, LAS float* scr, int lane) {
    unsigned char* ws = a.ws;
    const int layer = it / CV_LAYER; int r = it - layer * CV_LAYER;
    if (r < CV_WIN) { const int kb = r / 184, nb = r % 184;
        transpose_item(a.in[I_WIN] + (size_t)layer * D * INW, D, INW, (bf16*)(ws + WS_WIN) + (size_t)layer * INW * D, nb * 32, nb * 32, kb * 64, scr, lane); return; }
    r -= CV_WIN;
    if (r < CV_GLU) { const int kb = r / 64, nb = r % 64;
        transpose_item(a.in[I_GLUW] + (size_t)layer * 256 * 2048, 256, 2048, (bf16*)(ws + WS_WGLU) + (size_t)layer * 2048 * 256, nb * 32, ilv128(nb * 32, 1024), kb * 64, scr, lane); return; }
    r -= CV_GLU;
    if (r < CV_PW) { const int kb = r / 32, nb = r % 32;
        transpose_item(a.in[I_PWW] + (size_t)layer * 256 * 1024, 256, 1024, (bf16*)(ws + WS_WPW) + (size_t)layer * 1024 * 256, nb * 32, nb * 32, kb * 64, scr, lane); return; }
    r -= CV_PW;
    if (r < CV_WO) { const int kb = r / 32, nb = r % 32;
        transpose_item(a.in[I_WO] + (size_t)layer * 512 * 1024, 512, 1024, (bf16*)(ws + WS_WO) + (size_t)layer * 1024 * 512, nb * 32, nb * 32, kb * 64, scr, lane); return; }
    r -= CV_WO;
    if (r < CV_WOUT) { const int kb = r / 32, nb = r % 32;
        transpose_item(a.in[I_WOUT] + (size_t)layer * 1024 * 1024, 1024, 1024, (bf16*)(ws + WS_WOUT) + (size_t)layer * 1024 * 1024, nb * 32, nb * 32, kb * 64, scr, lane); return; }
    r -= CV_WOUT;
    if (r < CV_GU) { const int e = r >> 10, rr = r & 1023, kb = rr >> 6, nb = rr & 63; const size_t le = (size_t)layer * NE + e;
        transpose_item(a.in[I_GUW] + le * 1024 * 2048, 1024, 2048, (bf16*)(ws + WS_WGU) + le * 2048 * 1024, nb * 32, ilv128(nb * 32, 1024), kb * 64, scr, lane); return; }
    r -= CV_GU;
    { const int e = r >> 9, rr = r & 511, kb = rr >> 5, nb = rr & 31; const size_t le = (size_t)layer * NE + e;
        transpose_item(a.in[I_DW] + le * 1024 * 1024, 1024, 1024, (bf16*)(ws + WS_WD) + le * 1024 * 1024, nb * 32, nb * 32, kb * 64, scr, lane); }
}

__device__ __forceinline__ void ssm_build(const Args& a, int layer, int g, LAS unsigned char* lds, int tid) {
    LAS f32x2* pw = (LAS f32x2*)lds;
    LAS f32x2* Bb = (LAS f32x2*)(lds + 33792);
    LAS f32x2* Cm = (LAS f32x2*)(lds + 50176);
    LAS float* Kt = (LAS float*)(lds + 66560);
    const float* lam_re = a.in[I_LRE]; const float* lam_im = a.in[I_LIM]; const float* log_dt = a.in[I_LDT];
    __syncthreads();
    for (int idx = tid; idx < 2 * 33 * 64; idx += NTHR) { const int dir = idx / (33 * 64), rem = idx % (33 * 64), t = rem >> 6, p = rem & 63;
        const int pi = ((layer * 2 + dir) * 16 + g) * 64 + p;
        const float lr = fminf(lam_re[pi], -1e-4f), li = lam_im[pi], dt = expf(log_dt[(layer * 2 + dir) * 16 + g]);
        const float mag = expf(lr * dt * (float)t); float sn, cs; sincosf(li * dt * (float)t, &sn, &cs);
        pw[idx] = (f32x2){mag * cs, mag * sn}; }
    __syncthreads();
    for (int idx = tid; idx < 2048; idx += NTHR) { const int dir = idx >> 10;
        { const int p = (idx >> 4) & 63, m = idx & 15; const int pi = ((layer * 2 + dir) * 16 + g) * 64 + p;
          const float lr = fminf(lam_re[pi], -1e-4f), li = lam_im[pi]; const f32x2 lb = pw[(dir * 33 + 1) * 64 + p];
          const float nr = lb.x - 1.f, ni = lb.y, den = lr * lr + li * li, cr = (nr * lr + ni * li) / den, ci = (ni * lr - nr * li) / den;
          const float br = a.in[I_BRE][(size_t)pi * 16 + m], bi = a.in[I_BIM][(size_t)pi * 16 + m];
          Bb[idx] = (f32x2){cr * br - ci * bi, cr * bi + ci * br}; }
        { const int m = (idx >> 6) & 15, p = idx & 63; const size_t ci = ((size_t)((layer * 2 + dir) * 16 + g) * 16 + m) * 64 + p;
          Cm[idx] = (f32x2){a.in[I_CRE][ci], a.in[I_CIM][ci]}; } }
    __syncthreads();
    for (int idx = tid; idx < 2 * 32 * 256; idx += NTHR) { const int dir = idx >> 13, t = (idx >> 8) & 31, m = (idx >> 4) & 15, mp = idx & 15; float s = 0.f;
        for (int p = 0; p < 64; ++p) { const f32x2 c = Cm[(dir * 16 + m) * 64 + p], w = pw[(dir * 33 + t) * 64 + p], bb = Bb[(dir * 64 + p) * 16 + mp];
            s += (c.x * w.x - c.y * w.y) * bb.x - (c.x * w.y + c.y * w.x) * bb.y; }
        Kt[idx] = s; }
    __syncthreads();
    bf16* W1 = (bf16*)(a.ws + WS_SW1) + (size_t)(layer * 16 + g) * 768 * 512;
    for (int ch = tid; ch < 768 * 64; ch += NTHR) { const int n = ch >> 6, k8 = (ch & 63) << 3, j = k8 >> 4, mp0 = k8 & 15; float v[8];
        if (n < 512) { const int i = n >> 4, m = n & 15; const float dsk = a.in[I_SD][layer * 256 + g * 16 + m];
#pragma unroll
            for (int q = 0; q < 8; ++q) { const int mp = mp0 + q; float x = 0.f;
                if (j <= i) x += Kt[((i - j) * 16 + m) * 16 + mp];
                if (j >= i) x += Kt[((32 + (j - i)) * 16 + m) * 16 + mp];
                if (j == i && m == mp) x += dsk;
                v[q] = x; } }
        else { const int q_ = n - 512, dir = q_ >> 7, part = (q_ >> 6) & 1, p = q_ & 63, tp = dir ? j : 31 - j; const f32x2 w = pw[(dir * 33 + tp) * 64 + p];
#pragma unroll
            for (int q = 0; q < 8; ++q) { const f32x2 bb = Bb[(dir * 64 + p) * 16 + mp0 + q]; v[q] = part ? (w.x * bb.y + w.y * bb.x) : (w.x * bb.x - w.y * bb.y); } }
        *(GAS v4u*)(W1 + (size_t)n * 512 + k8) = pack8(v); }
    bf16* W2 = (bf16*)(a.ws + WS_SW2) + (size_t)(layer * 16 + g) * 512 * 256;
    for (int ch = tid; ch < 512 * 32; ch += NTHR) { const int n = ch >> 5, k8 = (ch & 31) << 3, i = n >> 4, m = n & 15, dir = k8 >> 7, part = (k8 >> 6) & 1, p0 = k8 & 63, tp = dir ? 32 - i : i + 1; float v[8];
#pragma unroll
        for (int q = 0; q < 8; ++q) { const f32x2 c = Cm[(dir * 16 + m) * 64 + p0 + q], w = pw[(dir * 33 + tp) * 64 + p0 + q];
            v[q] = part ? -(c.x * w.y + c.y * w.x) : (c.x * w.x - c.y * w.y); }
        *(GAS v4u*)(W2 + (size_t)n * 256 + k8) = pack8(v); }
    if (tid < 128) { const int dir = tid >> 6, p = tid & 63; const f32x2 w = pw[(dir * 33 + 32) * 64 + p];
        float* lc = (float*)(a.ws + WS_LAMC) + ((size_t)((layer * 2 + dir) * 16 + g) * 64 + p) * 2; lc[0] = w.x; lc[1] = w.y; }
    __syncthreads();
}

__device__ __forceinline__ void row_norm_mod(f32x4 (&v)[4], const float* g, const float* shift, const float* scale, int lane) {
    float s = 0.f;
#pragma unroll
    for (int j = 0; j < 4; ++j) s += (v[j].x * v[j].x + v[j].y * v[j].y) + (v[j].z * v[j].z + v[j].w * v[j].w);
    const float r = rsqrtf(wave_sum(s) * (1.f / D) + EPS);
#pragma unroll
    for (int j = 0; j < 4; ++j) { const f32x4 gg = *(const GAS f32x4*)(g + 4 * lane + 256 * j), sh = *(const GAS f32x4*)(shift + 4 * lane + 256 * j), sc = *(const GAS f32x4*)(scale + 4 * lane + 256 * j);
        v[j] = v[j] * r * gg * (1.f + sc) + sh; }
}
__device__ __forceinline__ void store_row_bf16(bf16* orow, const f32x4 (&v)[4], int lane) {
#pragma unroll
    for (int j = 0; j < 4; ++j) { v2u w; w.x = pk2(v[j].x, v[j].y); w.y = pk2(v[j].z, v[j].w); *(GAS v2u*)(orow + 4 * lane + 256 * j) = w; }
}

__device__ __forceinline__ void p0_prologue(const Args& a, LAS unsigned char* lds, int tid, int lane, int wave, int blk, int G) {
    LAS float* sT = (LAS float*)(lds + 69632);
    LAS float* red = (LAS float*)(lds + 106496);
    for (int i = tid; i < 9 * 1024; i += NTHR) { const float v = i < 8192 ? a.in[I_C][i] : a.in[I_CCTX][i - 8192]; sT[i] = silu_(v); }
    __syncthreads();
    float* mod = (float*)(a.ws + WS_MOD);
    for (int item = blk; item < DEPTH * 96; item += G) { const int layer = item / 96, cb = item % 96, col = cb * 64 + lane, k0 = wave * 128;
        const float* wp = a.in[I_ADAW] + ((size_t)layer * 1024 + k0) * 6144 + col;
        float acc[9];
#pragma unroll
        for (int r = 0; r < 9; ++r) acc[r] = 0.f;
#pragma unroll 8
        for (int kk = 0; kk < 128; ++kk) { const float w = wp[(size_t)kk * 6144];
#pragma unroll
            for (int r = 0; r < 9; ++r) acc[r] += sT[r * 1024 + k0 + kk] * w; }
#pragma unroll
        for (int r = 0; r < 9; ++r) red[(wave * 9 + r) * 64 + lane] = acc[r];
        __syncthreads();
        for (int o = tid; o < 9 * 64; o += NTHR) { const int r = o >> 6, l = o & 63; float s = 0.f;
#pragma unroll
            for (int w = 0; w < 8; ++w) s += red[(w * 9 + r) * 64 + l];
            mod[(size_t)(layer * 9 + r) * 6144 + cb * 64 + l] = s + a.in[I_ADAB][layer * 6144 + cb * 64 + l]; }
        __syncthreads();
    }
    if (blk >= G - 64) { const int u = blk - (G - 64); ssm_build(a, u >> 4, u & 15, lds, tid); }
    __syncthreads();
    LAS float* scr = (LAS float*)(lds + wave * 8448);
    const int gw = blk * NWAVES + wave, NGW = G * NWAVES;
    for (int it = gw; it < DEPTH * CV_LAYER; it += NGW) convert_item(a, it, scr, lane);
}

__device__ __forceinline__ void p0b_norm(const Args& a, int lane, int wave, int blk, int G) {
    float* xres = (float*)(a.ws + WS_X); bf16* H = (bf16*)(a.ws + WS_H); const float* mod = (const float*)(a.ws + WS_MOD);
    for (int row = blk * NWAVES + wave; row < T; row += G * NWAVES) {
        const float* src = row < TCTX ? a.in[I_CTX] + (size_t)row * D : a.in[I_X] + (size_t)(row - TCTX) * D;
        f32x4 v[4];
#pragma unroll
        for (int j = 0; j < 4; ++j) { v[j] = *(const GAS f32x4*)(src + 4 * lane + 256 * j); *(GAS f32x4*)(xres + (size_t)row * D + 4 * lane + 256 * j) = v[j]; }
        const float* mr = mod + (size_t)(0 * 9 + modrow(row)) * 6144;
        row_norm_mod(v, a.in[I_N1G], mr, mr + 1024, lane);
        store_row_bf16(H + (size_t)row * D, v, lane);
    }
}

typedef pg8::Unit Unit;
#define EPI_ROWS(ai, m) (u.pm * 256 + wr * 64 + fr + (ai) * 128 + (m) * 16)

struct EpiZ {
    static constexpr bool PERM = true, AFTER_DRAIN = false;
    bf16* O; int ldc;
    __device__ __forceinline__ void operator()(const f32x4 (&acc)[2][2][4][2], const Unit& u, int wr, int wc, int fr, int fq) const {
        const int col0 = u.pn * 256 + wc * 32 + 8 * fq;
#pragma unroll
        for (int ai = 0; ai < 2; ++ai)
#pragma unroll
            for (int m = 0; m < 4; ++m) { bf16* rowp = O + (size_t)EPI_ROWS(ai, m) * ldc + col0;
#pragma unroll
                for (int bj = 0; bj < 2; ++bj) { const f32x4 v0 = acc[ai][bj][m][0], v1 = acc[ai][bj][m][1]; v4u w; w.x = pk2(v0[0], v0[1]); w.y = pk2(v0[2], v0[3]); w.z = pk2(v1[0], v1[1]); w.w = pk2(v1[2], v1[3]);
                    *(GAS v4u*)(rowp + bj * 128) = w; } }
    }
};
struct EpiGlu {
    static constexpr bool PERM = true, AFTER_DRAIN = false;
    bf16* O; const bf16* Z; const float* bias;
    __device__ __forceinline__ void operator()(const f32x4 (&acc)[2][2][4][2], const Unit& u, int wr, int wc, int fr, int fq) const {
        const int colo = u.pn * 128 + wc * 32 + 8 * fq;
        float ba[8], bg[8];
#pragma unroll
        for (int q = 0; q < 8; ++q) { ba[q] = bias[colo + q]; bg[q] = bias[1024 + colo + q]; }
#pragma unroll
        for (int ai = 0; ai < 2; ++ai)
#pragma unroll
            for (int m = 0; m < 4; ++m) { const size_t row = EPI_ROWS(ai, m);
                float gs[8]; unpack8(*(const GAS v4u*)(Z + row * INW + ZGS + colo), gs); float o[8];
#pragma unroll
                for (int q = 0; q < 8; ++q) { const float av = acc[ai][0][m][q >> 2][q & 3] + ba[q], gv = acc[ai][1][m][q >> 2][q & 3] + bg[q]; o[q] = av * sigm(gv) * sigm(gs[q]); }
                *(GAS v4u*)(O + row * D + colo) = pack8(o); asm volatile("" ::: "memory"); }
    }
};
struct EpiPw {
    static constexpr bool PERM = true, AFTER_DRAIN = false;
    bf16* O; const bf16* Z; const float* bias;
    __device__ __forceinline__ void operator()(const f32x4 (&acc)[2][2][4][2], const Unit& u, int wr, int wc, int fr, int fq) const {
#pragma unroll
        for (int bj = 0; bj < 2; ++bj) { const int col = u.pn * 256 + bj * 128 + wc * 32 + 8 * fq; float bb[8];
#pragma unroll
            for (int q = 0; q < 8; ++q) bb[q] = bias[col + q];
#pragma unroll
            for (int ai = 0; ai < 2; ++ai)
#pragma unroll
                for (int m = 0; m < 4; ++m) { const size_t row = EPI_ROWS(ai, m);
                    float gc[8]; unpack8(*(const GAS v4u*)(Z + row * INW + ZGC + col), gc); float o[8];
#pragma unroll
                    for (int q = 0; q < 8; ++q) o[q] = (acc[ai][bj][m][q >> 2][q & 3] + bb[q]) * sigm(gc[q]);
                    *(GAS v4u*)(O + row * D + col) = pack8(o); asm volatile("" ::: "memory"); } }
    }
};
struct EpiWo {
    static constexpr bool PERM = true, AFTER_DRAIN = false;
    bf16* M1; const bf16* M2; const bf16* Z;
    __device__ __forceinline__ void operator()(const f32x4 (&acc)[2][2][4][2], const Unit& u, int wr, int wc, int fr, int fq) const {
#pragma unroll
        for (int bj = 0; bj < 2; ++bj) { const int col = u.pn * 256 + bj * 128 + wc * 32 + 8 * fq;
#pragma unroll
            for (int ai = 0; ai < 2; ++ai)
#pragma unroll
                for (int m = 0; m < 4; ++m) { const size_t row = EPI_ROWS(ai, m);
                    float gr[8], a1[8], a2[8]; unpack8(*(const GAS v4u*)(Z + row * INW + ZGR + col), gr); unpack8(*(const GAS v4u*)(M1 + row * D + col), a1); unpack8(*(const GAS v4u*)(M2 + row * D + col), a2); float o[8];
#pragma unroll
                    for (int q = 0; q < 8; ++q) o[q] = acc[ai][bj][m][q >> 2][q & 3] * sigm(gr[q]) + a1[q] + a2[q];
                    *(GAS v4u*)(M1 + row * D + col) = pack8(o); asm volatile("" ::: "memory"); } }
    }
};
struct EpiOut {
    static constexpr bool PERM = true, AFTER_DRAIN = false;
    float* X; const float* modl;
    __device__ __forceinline__ void operator()(const f32x4 (&acc)[2][2][4][2], const Unit& u, int wr, int wc, int fr, int fq) const {
        const int mr = u.pm < 8 ? 8 : (u.pm - 8) >> 3; const float* gate = modl + (size_t)mr * 6144 + 2048;
#pragma unroll
        for (int bj = 0; bj < 2; ++bj) { const int col = u.pn * 256 + bj * 128 + wc * 32 + 8 * fq;
            const f32x4 g0 = *(const GAS f32x4*)(gate + col), g1 = *(const GAS f32x4*)(gate + col + 4);
#pragma unroll
            for (int ai = 0; ai < 2; ++ai)
#pragma unroll
                for (int m = 0; m < 4; ++m) { float* xp = X + (size_t)EPI_ROWS(ai, m) * D + col;
                    const f32x4 x0 = *(const GAS f32x4*)xp, x1 = *(const GAS f32x4*)(xp + 4);
                    *(GAS f32x4*)xp = x0 + g0 * acc[ai][bj][m][0]; *(GAS f32x4*)(xp + 4) = x1 + g1 * acc[ai][bj][m][1]; asm volatile("" ::: "memory"); } }
    }
};
struct EpiGu {
    static constexpr bool PERM = true, AFTER_DRAIN = false;
    bf16* O; const float* bias;
    __device__ __forceinline__ void operator()(const f32x4 (&acc)[2][2][4][2], const Unit& u, int wr, int wc, int fr, int fq) const {
        const int e = u.pn >> 3, colo = (u.pn & 7) * 128 + wc * 32 + 8 * fq; const float* be = bias + (size_t)e * 2048;
        float bgt[8], bup[8];
#pragma unroll
        for (int q = 0; q < 8; ++q) { bgt[q] = be[colo + q]; bup[q] = be[1024 + colo + q]; }
#pragma unroll
        for (int ai = 0; ai < 2; ++ai)
#pragma unroll
            for (int m = 0; m < 4; ++m) { const size_t row = EPI_ROWS(ai, m); float o[8];
#pragma unroll
                for (int q = 0; q < 8; ++q) { const float gt = fminf(acc[ai][0][m][q >> 2][q & 3] + bgt[q], 7.f), up = fminf(fmaxf(acc[ai][1][m][q >> 2][q & 3] + bup[q], -7.f), 7.f);
                    o[q] = (up + 1.f) * gt * sigm(gt * 1.702f); }
                *(GAS v4u*)(O + row * D + colo) = pack8(o); asm volatile("" ::: "memory"); }
    }
};
struct EpiDown {
    static constexpr bool PERM = true, AFTER_DRAIN = false;
    bf16* O; const float* bias;
    __device__ __forceinline__ void operator()(const f32x4 (&acc)[2][2][4][2], const Unit& u, int wr, int wc, int fr, int fq) const {
        const int e = u.pn >> 2; const float* be = bias + (size_t)e * 1024;
#pragma unroll
        for (int bj = 0; bj < 2; ++bj) { const int col = (u.pn & 3) * 256 + bj * 128 + wc * 32 + 8 * fq; float bb[8];
#pragma unroll
            for (int q = 0; q < 8; ++q) bb[q] = be[col + q];
#pragma unroll
            for (int ai = 0; ai < 2; ++ai)
#pragma unroll
                for (int m = 0; m < 4; ++m) { const size_t row = EPI_ROWS(ai, m); float o[8];
#pragma unroll
                    for (int q = 0; q < 8; ++q) o[q] = acc[ai][bj][m][q >> 2][q & 3] + bb[q];
                    *(GAS v4u*)(O + row * D + col) = pack8(o); asm volatile("" ::: "memory"); } }
    }
};
struct MoeOrder {
    const int* info; int NC, nunits, G, c;
    __device__ __forceinline__ void init(const int* info_, int NC_, int G_, int c_) { info = info_; NC = NC_; G = G_; c = c_; nunits = info_[0] * NC_; }
    __device__ __forceinline__ bool next(int i, Unit& u) const {
        const int L = i * G + c; if (L >= nunits) return false;
        const int gi = L / (8 * NC), rem = L - gi * 8 * NC, pm = gi * 8 + (rem & 7), cn = rem >> 3;
        u.pm = pm; u.pn = info[64 + pm] * NC + cn; return true;
    }
    __device__ __forceinline__ void a_ready(const Unit&) const {}
    __device__ __forceinline__ void done(const Unit&) const {}
};

__device__ __forceinline__ void prep_unit(const Args& a, int u, LAS unsigned char* lds, int tid) {
    const int c = u % 18, h = (u / 18) & 3, b = u / 72;
    const int n0 = c * 128, rowbase = c < 2 ? b * CTXL + n0 : TCTX + b * LAT + (n0 - CTXL), i0 = n0 - CTXL; const bool lat = c >= 2;
    const bf16* Z = (const bf16*)(a.ws + WS_Z);
    bf16* Qr = (bf16*)(a.ws + WS_QR); bf16* Kr = (bf16*)(a.ws + WS_KR); bf16* Ktf = (bf16*)(a.ws + WS_KTF); bf16* Ktb = (bf16*)(a.ws + WS_KTB); bf16* Vt = (bf16*)(a.ws + WS_VT); bf16* Ug = (bf16*)(a.ws + WS_UG);
    LAS unsigned char* Kl = lds;
    LAS unsigned char* Vl = lds + 34816;
    LAS f32x2* ropeT = (LAS f32x2*)(lds + 69632);
    LAS float* zt = (LAS float*)(lds + 69632 + 16384);
    __syncthreads();
    for (int i = tid; i < 2048; i += NTHR) { const int pos = i >> 5, f = i & 31; const float inv = exp2f(-(float)f * (13.287712379549449f / 32.f)); float sn, cs; sincosf((float)pos * inv, &sn, &cs); ropeT[i] = (f32x2){cs, sn}; }
    if (tid < 256) { const int dir = tid >> 7, j = tid & 127; const float lg = lg2gamma(dir ? 3 - h : h); zt[tid] = exp2f(lg * (float)(dir ? j : 127 - j)); }
    __syncthreads();
    const size_t bh = (size_t)b * 4 + h;
    for (int t = tid; t < 1024; t += NTHR) { const int r = t >> 3, pc = t & 7, half = pc >> 2, f0 = (pc & 3) * 8, d1 = half * 64 + f0, d2 = d1 + 32;
        const bf16* zr = Z + (size_t)(rowbase + r) * INW;
        float q1[8], q2[8], k1[8], k2[8];
        unpack8(*(const GAS v4u*)(zr + ZQ + h * 128 + d1), q1); unpack8(*(const GAS v4u*)(zr + ZQ + h * 128 + d2), q2);
        unpack8(*(const GAS v4u*)(zr + ZK + h * 128 + d1), k1); unpack8(*(const GAS v4u*)(zr + ZK + h * 128 + d2), k2);
        const float ks = 0.08838834764831845f;
        if (lat) { const int i = i0 + r, pos = half ? (i & 63) : (i >> 6);
#pragma unroll
            for (int q = 0; q < 8; ++q) { const f32x2 cs = ropeT[pos * 32 + f0 + q];
                const float a1 = q1[q] * cs.x - q2[q] * cs.y, a2 = q1[q] * cs.y + q2[q] * cs.x; q1[q] = a1; q2[q] = a2;
                const float b1 = k1[q] * cs.x - k2[q] * cs.y, b2 = k1[q] * cs.y + k2[q] * cs.x; k1[q] = b1; k2[q] = b2; } }
#pragma unroll
        for (int q = 0; q < 8; ++q) { k1[q] *= ks; k2[q] *= ks; }
        const size_t o = (bh * SEQC + n0 + r) * 128;
        const v4u kw1 = pack8(k1), kw2 = pack8(k2);
        *(GAS v4u*)(Qr + o + d1) = pack8(q1); *(GAS v4u*)(Qr + o + d2) = pack8(q2);
        *(GAS v4u*)(Kr + o + d1) = kw1; *(GAS v4u*)(Kr + o + d2) = kw2;
        *(LAS v4u*)(Kl + r * 272 + d1 * 2) = kw1; *(LAS v4u*)(Kl + r * 272 + d2 * 2) = kw2; }
    for (int t = tid; t < 2048; t += NTHR) { const int r = t >> 4, cc = t & 15; *(LAS v4u*)(Vl + r * 272 + cc * 16) = *(const GAS v4u*)(Z + (size_t)(rowbase + r) * INW + ZV + h * 128 + cc * 8); }
    for (int t = tid; t < 1024; t += NTHR) { const int r = t >> 3, ch = t & 7, g = 4 * h + (ch >> 1), hf = ch & 1;
        *(GAS v4u*)(Ug + ((size_t)(g * NB + b) * SEQC + n0 + r) * 16 + hf * 8) = *(const GAS v4u*)(Z + (size_t)(rowbase + r) * INW + ZU + g * 16 + hf * 8); }
    __syncthreads();
    for (int t = tid; t < 2048; t += NTHR) { const int d = t & 127, j0 = (t >> 7) * 8; float kf[8], kb[8], vv[8];
#pragma unroll
        for (int q = 0; q < 8; ++q) { const float kv = bf2f(*(const LAS unsigned short*)(Kl + (j0 + q) * 272 + d * 2)); kf[q] = kv * zt[j0 + q]; kb[q] = kv * zt[128 + j0 + q];
            vv[q] = bf2f(*(const LAS unsigned short*)(Vl + (j0 + q) * 272 + d * 2)); }
        const size_t o = (bh * 128 + d) * SEQC + n0 + j0;
        *(GAS v4u*)(Ktf + o) = pack8(kf); *(GAS v4u*)(Ktb + o) = pack8(kb); *(GAS v4u*)(Vt + o) = pack8(vv); }
}

__device__ __forceinline__ void conv_unit(const Args& a, int layer, int u, LAS unsigned char* lds, int tid, int lane, int wave) {
    int seqrow, L, tile;
    if (u < 32) { seqrow = (u >> 2) * CTXL; L = CTXL; tile = u & 3; } else { const int v = u - 32; seqrow = TCTX + (v >> 5) * LAT; L = LAT; tile = v & 31; }
    const int t0 = tile * 64;
    const bf16* Z = (const bf16*)(a.ws + WS_Z); bf16* cact = (bf16*)(a.ws + WS_CACT);
    LAS unsigned short* hb = (LAS unsigned short*)lds;
    LAS float* cb = (LAS float*)(lds + 49152);
    __syncthreads();
    for (int idx = tid; idx < 94 * 32; idx += NTHR) { const int r = idx >> 5, ch = idx & 31, tp = t0 - 15 + r; v4u w = (v4u){0u, 0u, 0u, 0u};
        if (tp >= 0 && tp < L) { const bf16* zr = Z + (size_t)(seqrow + tp) * INW; float av[8], gv[8]; unpack8(*(const GAS v4u*)(zr + ZCA + ch * 8), av); unpack8(*(const GAS v4u*)(zr + ZCG + ch * 8), gv);
#pragma unroll
            for (int q = 0; q < 8; ++q) av[q] = av[q] * sigm(gv[q]);
            w = pack8(av); }
        *(LAS v4u*)(hb + r * 256 + ch * 8) = w; }
    __syncthreads();
    { const int c = tid & 255, hf = tid >> 8; float w[31];
#pragma unroll
        for (int k = 0; k < 31; ++k) w[k] = a.in[I_DWW][(size_t)(layer * 31 + k) * 256 + c];
        const float bias = a.in[I_DWB][layer * 256 + c];
        for (int tt = 0; tt < 8; ++tt) { const int r0 = hf * 32 + tt * 4; float acc[4] = {bias, bias, bias, bias};
#pragma unroll
            for (int k = 0; k < 34; ++k) { const float v = bf2f(hb[(r0 + k) * 256 + c]);
#pragma unroll
                for (int o = 0; o < 4; ++o) if (k - o >= 0 && k - o < 31) acc[o] += w[k - o] * v; }
#pragma unroll
            for (int o = 0; o < 4; ++o) cb[(r0 + o) * 256 + c] = acc[o]; } }
    __syncthreads();
    for (int q = 0; q < 8; ++q) { const int tl = wave * 8 + q; const f32x4 v = *(const LAS f32x4*)(cb + tl * 256 + 4 * lane);
        const float mean = wave_sum((v.x + v.y) + (v.z + v.w)) * (1.f / 256.f); const f32x4 dv = v - mean;
        const float var = wave_sum((dv.x * dv.x + dv.y * dv.y) + (dv.z * dv.z + dv.w * dv.w)) * (1.f / 256.f), rstd = rsqrtf(var + EPS);
        const f32x4 g = *(const GAS f32x4*)(a.in[I_LNG] + layer * 256 + 4 * lane), bb = *(const GAS f32x4*)(a.in[I_LNB] + layer * 256 + 4 * lane);
        const f32x4 y = dv * rstd * g + bb; v2u w; w.x = pk2(silu_(y.x), silu_(y.y)); w.y = pk2(silu_(y.z), silu_(y.w));
        *(GAS v2u*)(cact + (size_t)(seqrow + t0 + tl) * 256 + 4 * lane) = w; }
}

__device__ __forceinline__ void ssm_gemm1_unit(const Args& a, int layer, int u, LAS unsigned char* lds, int tid, int lane, int wave) {
    const int ct = u % 6, rt = (u / 6) % 9, g = u / 54;
    const bf16* A = (const bf16*)(a.ws + WS_UG) + ((size_t)g * SROWS + rt * 64) * 512;
    const bf16* B = (const bf16*)(a.ws + WS_SW1) + ((size_t)(layer * 16 + g) * 768 + ct * 128) * 512;
    LAS unsigned char* As = lds; LAS unsigned char* Bs = lds + 33792;
    const int wr = wave >> 1, wc = wave & 1, fr = lane & 15, fq = lane >> 4;
    f32x4 acc[4];
#pragma unroll
    for (int t = 0; t < 4; ++t) acc[t] = (f32x4){0.f, 0.f, 0.f, 0.f};
    for (int kh = 0; kh < 2; ++kh) {
        __syncthreads();
        bg_stage<64, 256>(As, A + kh * 256, 512, tid); bg_stage<128, 256>(Bs, B + kh * 256, 512, tid);
        __syncthreads();
        bg_mma<4, 256>(acc, As, Bs, 16 * wr, 64 * wc, fr, fq);
    }
    float* Y1 = (float*)(a.ws + WS_Y1); float* Zc = (float*)(a.ws + WS_ZC);
#pragma unroll
    for (int t = 0; t < 4; ++t)
#pragma unroll
        for (int r = 0; r < 4; ++r) { const int row = rt * 64 + 16 * wr + 4 * fq + r, col = ct * 128 + 64 * wc + 16 * t + fr;
            if (ct < 4) Y1[((size_t)g * SROWS + row) * 512 + col] = acc[t][r]; else Zc[((size_t)g * SROWS + row) * 256 + col - 512] = acc[t][r]; }
}
__device__ __forceinline__ void ssm_scan_unit(const Args& a, int layer, int u, int tid) {
    const int id = u * NTHR + tid, p = id & 63, g = (id >> 6) & 15, dir = (id >> 10) & 1, b = id >> 11;
    const float* lc = (const float*)(a.ws + WS_LAMC) + ((size_t)((layer * 2 + dir) * 16 + g) * 64 + p) * 2; const float lr = lc[0], li = lc[1];
    const float* Zc = (const float*)(a.ws + WS_ZC) + ((size_t)g * SROWS + b * NCH) * 256 + dir * 128 + p;
    bf16* Sin = (bf16*)(a.ws + WS_SIN) + ((size_t)g * SROWS + b * NCH) * 256 + dir * 128 + p;
    float sr = 0.f, si = 0.f;
    for (int s0 = 0; s0 < NCH; s0 += 8) { float zr[8], zi[8];
#pragma unroll
        for (int q = 0; q < 8; ++q) { const int st = s0 + q, c = dir == 0 ? st : (st < 8 ? 7 - st : 79 - st); zr[q] = Zc[(size_t)c * 256]; zi[q] = Zc[(size_t)c * 256 + 64]; }
#pragma unroll
        for (int q = 0; q < 8; ++q) { const int st = s0 + q, c = dir == 0 ? st : (st < 8 ? 7 - st : 79 - st);
            Sin[(size_t)c * 256] = (bf16)f2bf(sr); Sin[(size_t)c * 256 + 64] = (bf16)f2bf(si);
            const float nr = lr * sr - li * si + zr[q], ni = lr * si + li * sr + zi[q]; sr = nr; si = ni; } }
}
__device__ __forceinline__ void ssm_gemm2_unit(const Args& a, int layer, int u, LAS unsigned char* lds, int tid, int lane, int wave) {
    const int ct = u & 3, rt = (u >> 2) % 9, g = u / 36;
    const bf16* A = (const bf16*)(a.ws + WS_SIN) + ((size_t)g * SROWS + rt * 64) * 256;
    const bf16* B = (const bf16*)(a.ws + WS_SW2) + ((size_t)(layer * 16 + g) * 512 + ct * 128) * 256;
    LAS unsigned char* As = lds; LAS unsigned char* Bs = lds + 33792;
    const int wr = wave >> 1, wc = wave & 1, fr = lane & 15, fq = lane >> 4;
    f32x4 acc[4];
#pragma unroll
    for (int t = 0; t < 4; ++t) acc[t] = (f32x4){0.f, 0.f, 0.f, 0.f};
    __syncthreads();
    bg_stage<64, 256>(As, A, 256, tid); bg_stage<128, 256>(Bs, B, 256, tid);
    __syncthreads();
    bg_mma<4, 256>(acc, As, Bs, 16 * wr, 64 * wc, fr, fq);
    const float* Y1 = (const float*)(a.ws + WS_Y1); bf16* sact = (bf16*)(a.ws + WS_SACT);
#pragma unroll
    for (int t = 0; t < 4; ++t)
#pragma unroll
        for (int r = 0; r < 4; ++r) { const int R = rt * 64 + 16 * wr + 4 * fq + r, col = ct * 128 + 64 * wc + 16 * t + fr, b = R / NCH, ch = R % NCH, n = ch * 32 + (col >> 4);
            const float y = acc[t][r] + Y1[((size_t)g * SROWS + R) * 512 + col];
            sact[(size_t)tokrow(b, n) * 256 + g * 16 + (col & 15)] = (bf16)f2bf(gelu_tanh(y)); }
}

__device__ __forceinline__ void ret_state_unit(const Args& a, int u, LAS unsigned char* lds, int tid, int lane, int wave) {
    const int eb = u & 3, dir = (u >> 2) & 1, h = (u >> 3) & 3, b = u >> 5;
    const size_t bh = (size_t)b * 4 + h;
    const bf16* vt = (const bf16*)(a.ws + WS_VT) + (bh * 128 + eb * 32) * SEQC;
    const bf16* kz = (const bf16*)(a.ws + (dir ? WS_KTB : WS_KTF)) + bh * 128 * SEQC;
    bf16* Sp = (bf16*)(a.ws + WS_SPREV) + ((bh * 2 + dir) * 18) * (size_t)16384;
    const float gch = exp2f(128.f * lg2gamma(dir ? 3 - h : h));
    LAS unsigned char* As = lds; LAS unsigned char* Bs = lds + 8704;
    const int wr = wave & 1, wc = wave >> 1, fr = lane & 15, fq = lane >> 4;
    f32x4 acc[2] = {(f32x4){0.f, 0.f, 0.f, 0.f}, (f32x4){0.f, 0.f, 0.f, 0.f}};
    for (int st = 0; st < 18; ++st) { const int c = dir == 0 ? st : (st < 2 ? 1 - st : 19 - st);
#pragma unroll
        for (int t = 0; t < 2; ++t)
#pragma unroll
            for (int r = 0; r < 4; ++r) Sp[(size_t)c * 16384 + (eb * 32 + 16 * wr + 4 * fq + r) * 128 + 32 * wc + 16 * t + fr] = (bf16)f2bf(acc[t][r]);
        if (st == 17) break;
        const int n0 = c * 128;
        __syncthreads();
        { const int r = tid >> 4, cc = tid & 15; *(LAS v4u*)(As + r * 272 + cc * 16) = *(const GAS v4u*)(vt + (size_t)r * SEQC + n0 + cc * 8); }
        bg_stage<128, 128>(Bs, kz + n0, SEQC, tid);
        __syncthreads();
        acc[0] = acc[0] * gch; acc[1] = acc[1] * gch;
        bg_mma<2, 128>(acc, As, Bs, 16 * wr, 32 * wc, fr, fq);
    }
}
__device__ __forceinline__ void ret_out_unit(const Args& a, int u, LAS unsigned char* lds, int tid, int lane, int wave) {
    const int c = u % 18, h = (u / 18) & 3, b = u / 72;
    const int n0 = c * 128, rowbase = c < 2 ? b * CTXL + n0 : TCTX + b * LAT + (n0 - CTXL);
    const size_t bh = (size_t)b * 4 + h;
    const bf16* Qg = (const bf16*)(a.ws + WS_QR) + (bh * SEQC + n0) * 128;
    const bf16* Kg = (const bf16*)(a.ws + WS_KR) + (bh * SEQC + n0) * 128;
    const bf16* Vg = (const bf16*)(a.ws + WS_VT) + bh * 128 * SEQC + n0;
    const bf16* Sf = (const bf16*)(a.ws + WS_SPREV) + ((bh * 2 + 0) * 18 + c) * (size_t)16384;
    const bf16* Sb = (const bf16*)(a.ws + WS_SPREV) + ((bh * 2 + 1) * 18 + c) * (size_t)16384;
    LAS unsigned char* Qs = lds; LAS unsigned char* Bs = lds + 34816; LAS unsigned char* Ps = lds + 69632; LAS float* dtab = (LAS float*)(lds + 104448);
    const float lgf = lg2gamma(h), lgb = lg2gamma(3 - h);
    const int fr = lane & 15, fq = lane >> 4, ib = 16 * wave + 4 * fq;
    __syncthreads();
    if (tid < 255) { const int dl = tid - 127; dtab[tid] = dl > 0 ? exp2f(lgf * (float)dl) : (dl < 0 ? exp2f(lgb * (float)(-dl)) : 2.f); }
    bg_stage<128, 128>(Qs, Qg, 128, tid); bg_stage<128, 128>(Bs, Sf, 128, tid);
    __syncthreads();
    f32x4 o[8], s[8];
#pragma unroll
    for (int t = 0; t < 8; ++t) o[t] = (f32x4){0.f, 0.f, 0.f, 0.f};
    bg_mma<8, 128>(o, Qs, Bs, 16 * wave, 0, fr, fq);
    { f32x4 df;
#pragma unroll
      for (int r = 0; r < 4; ++r) df[r] = exp2f(lgf * (float)(ib + r + 1));
#pragma unroll
      for (int t = 0; t < 8; ++t) o[t] = o[t] * df; }
    __syncthreads();
    bg_stage<128, 128>(Bs, Sb, 128, tid);
    __syncthreads();
#pragma unroll
    for (int t = 0; t < 8; ++t) s[t] = (f32x4){0.f, 0.f, 0.f, 0.f};
    bg_mma<8, 128>(s, Qs, Bs, 16 * wave, 0, fr, fq);
    { f32x4 db;
#pragma unroll
      for (int r = 0; r < 4; ++r) db[r] = exp2f(lgb * (float)(128 - ib - r));
#pragma unroll
      for (int t = 0; t < 8; ++t) o[t] = o[t] + s[t] * db; }
    __syncthreads();
    bg_stage<128, 128>(Bs, Kg, 128, tid);
    __syncthreads();
#pragma unroll
    for (int t = 0; t < 8; ++t) s[t] = (f32x4){0.f, 0.f, 0.f, 0.f};
    bg_mma<8, 128>(s, Qs, Bs, 16 * wave, 0, fr, fq);
#pragma unroll
    for (int t = 0; t < 8; ++t)
#pragma unroll
        for (int r = 0; r < 4; ++r) { const int i = ib + r, j = 16 * t + fr; *(LAS unsigned short*)(Ps + i * 272 + j * 2) = (unsigned short)f2bf(s[t][r] * dtab[i - j + 127]); }
    __syncthreads();
    bg_stage<128, 128>(Bs, Vg, SEQC, tid);
    __syncthreads();
    bg_mma<8, 128>(o, Ps, Bs, 16 * wave, 0, fr, fq);
    const bf16* Z = (const bf16*)(a.ws + WS_Z); bf16* ract = (bf16*)(a.ws + WS_RACT);
#pragma unroll
    for (int r = 0; r < 4; ++r) { float ss = 0.f;
#pragma unroll
        for (int t = 0; t < 8; ++t) ss += o[t][r] * o[t][r];
        ss += __shfl_xor(ss, 1); ss += __shfl_xor(ss, 2); ss += __shfl_xor(ss, 4); ss += __shfl_xor(ss, 8);
        const float rinv = rsqrtf(ss * (1.f / 128.f) + EPS); const size_t row = rowbase + ib + r;
#pragma unroll
        for (int t = 0; t < 8; ++t) { const int e = 16 * t + fr; const float gt = bf2f(Z[row * INW + ZG + h * 128 + e]);
            ract[row * 512 + h * 128 + e] = (bf16)f2bf(o[t][r] * rinv * silu_(gt)); } }
}

__device__ __forceinline__ void moe_route(const Args& a, int layer, int row0, int RPB, LAS unsigned char* lds, int tid, int lane, int wave, int blk) {
    LAS float* hT = (LAS float*)lds;
    LAS float* part = (LAS float*)(lds + 65792);
    LAS float* lg = (LAS float*)(lds + 65792 + 16384);
    LAS int* histL = (LAS int*)(lds + 65792 + 16384 + 2048);
    const float* xres = (const float*)(a.ws + WS_X); bf16* H = (bf16*)(a.ws + WS_H);
    const float* modl = (const float*)(a.ws + WS_MOD) + (size_t)layer * 9 * 6144;
    const float* Wr = a.in[I_RW] + (size_t)layer * 1024 * 32; const float* br = a.in[I_RB] + layer * 32;
    int* ainfo = (int*)(a.ws + WS_AINFO); float* agate = (float*)(a.ws + WS_AGATE);
    __syncthreads();
    if (tid < 32) histL[tid] = 0;
    const int nsteps = (RPB + 15) >> 4, rbase = row0 + blk * RPB;
    for (int st = 0; st < nsteps; ++st) {
        __syncthreads();
#pragma unroll
        for (int q = 0; q < 2; ++q) { const int lr = 2 * wave + q, rl = st * 16 + lr; const bool valid = rl < RPB; const int row = rbase + (valid ? rl : RPB - 1);
            f32x4 v[4];
#pragma unroll
            for (int j = 0; j < 4; ++j) v[j] = *(const GAS f32x4*)(xres + (size_t)row * D + 4 * lane + 256 * j);
            const float* mr = modl + (size_t)modrow(row) * 6144;
            row_norm_mod(v, a.in[I_N2G] + layer * D, mr + 3072, mr + 4096, lane);
            if (valid) store_row_bf16(H + (size_t)row * D, v, lane);
#pragma unroll
            for (int j = 0; j < 4; ++j) *(LAS f32x4*)(hT + lr * 1028 + 4 * lane + 256 * j) = v[j]; }
        __syncthreads();
        { f32x4 c0 = (f32x4){0.f, 0.f, 0.f, 0.f}, c1 = c0; const int rr = lane & 15, kq = lane >> 4;
#pragma unroll 8
          for (int ks = 0; ks < 32; ++ks) { const int k = wave * 128 + ks * 4 + kq; const float av = hT[rr * 1028 + k], b0 = Wr[(size_t)k * 32 + rr], b1 = Wr[(size_t)k * 32 + 16 + rr];
              c0 = __builtin_amdgcn_mfma_f32_16x16x4f32(av, b0, c0, 0, 0, 0); c1 = __builtin_amdgcn_mfma_f32_16x16x4f32(av, b1, c1, 0, 0, 0); }
#pragma unroll
          for (int r = 0; r < 4; ++r) { part[(wave * 16 + 4 * kq + r) * 32 + rr] = c0[r]; part[(wave * 16 + 4 * kq + r) * 32 + 16 + rr] = c1[r]; } }
        __syncthreads();
        { const int r = tid >> 5, e = tid & 31; float s = br[e];
#pragma unroll
          for (int w = 0; w < 8; ++w) s += part[(w * 16 + r) * 32 + e];
          lg[r * 32 + e] = s; }
        __syncthreads();
        if (tid < 16 && st * 16 + tid < RPB) { const int row = rbase + st * 16 + tid;
            float v0 = -3.0e38f, v1 = -3.0e38f, v2 = -3.0e38f, v3 = -3.0e38f; int i0 = 0, i1 = 0, i2 = 0, i3 = 0;
            for (int e = 0; e < 32; ++e) { float x = lg[tid * 32 + e]; int xi = e;
                if (x > v0) { const float tv = v0; v0 = x; x = tv; const int ti = i0; i0 = xi; xi = ti; }
                if (x > v1) { const float tv = v1; v1 = x; x = tv; const int ti = i1; i1 = xi; xi = ti; }
                if (x > v2) { const float tv = v2; v2 = x; x = tv; const int ti = i2; i2 = xi; xi = ti; }
                if (x > v3) { v3 = x; i3 = xi; } }
            const float e1 = __expf(v1 - v0), e2 = __expf(v2 - v0), e3 = __expf(v3 - v0), inv = 1.f / (1.f + e1 + e2 + e3);
            const int r0 = __hip_atomic_fetch_add(histL + i0, 1, __ATOMIC_RELAXED, __HIP_MEMORY_SCOPE_WORKGROUP), r1 = __hip_atomic_fetch_add(histL + i1, 1, __ATOMIC_RELAXED, __HIP_MEMORY_SCOPE_WORKGROUP);
            const int r2 = __hip_atomic_fetch_add(histL + i2, 1, __ATOMIC_RELAXED, __HIP_MEMORY_SCOPE_WORKGROUP), r3 = __hip_atomic_fetch_add(histL + i3, 1, __ATOMIC_RELAXED, __HIP_MEMORY_SCOPE_WORKGROUP);
            ainfo[row * 4 + 0] = i0 | (r0 << 8); ainfo[row * 4 + 1] = i1 | (r1 << 8); ainfo[row * 4 + 2] = i2 | (r2 << 8); ainfo[row * 4 + 3] = i3 | (r3 << 8);
            agate[row * 4 + 0] = inv; agate[row * 4 + 1] = e1 * inv; agate[row * 4 + 2] = e2 * inv; agate[row * 4 + 3] = e3 * inv; }
    }
    __syncthreads();
    if (tid < 32) ((int*)a.ws + CW_HIST)[blk * 32 + tid] = histL[tid];
}
__device__ __forceinline__ void moe_gather(const Args& a, int row0, int RPB, LAS unsigned char* lds, int tid, int lane, int wave, int blk, int G) {
    LAS int* ptot = (LAS int*)lds;
    LAS int* pbas = (LAS int*)(lds + 2048);
    LAS int* pbase = (LAS int*)(lds + 4096);
    LAS int* pstart = (LAS int*)(lds + 4096 + 128);
    const int* hist = (const int*)a.ws + CW_HIST;
    __syncthreads();
    { const int e = tid & 31, seg = tid >> 5; int tot = 0, bas = 0;
#pragma unroll
      for (int q = 0; q < 16; ++q) { const int bb = seg * 16 + q; const int v = bb < G ? hist[bb * 32 + e] : 0; tot += v; bas += bb < blk ? v : 0; }
      ptot[seg * 32 + e] = tot; pbas[seg * 32 + e] = bas; }
    __syncthreads();
    if (tid < 32) { int tot = 0, bas = 0;
#pragma unroll
        for (int s = 0; s < 16; ++s) { tot += ptot[s * 32 + tid]; bas += pbas[s * 32 + tid]; }
        ptot[tid] = (tot + 255) >> 8; pbas[tid] = bas; }
    __syncthreads();
    if (tid < 32) { int st = 0; for (int e = 0; e < tid; ++e) st += ptot[e]; pstart[tid] = st; pbase[tid] = st * 256 + pbas[tid]; if (tid == 31) pstart[32] = st + ptot[31]; }
    __syncthreads();
    if (blk == 0) { int* info = (int*)a.ws + CW_MOE; const int nt = pstart[32], ntp = (nt + 7) & ~7;
        if (tid == 0) info[0] = ntp;
        for (int t = tid; t < XB_TILES; t += NTHR) { int e = 0; if (t < nt) { for (int q = 1; q < 32; ++q) if (pstart[q] <= t) e = q; } info[64 + t] = e; } }
    const int* ainfo = (const int*)(a.ws + WS_AINFO); int* aslot = (int*)(a.ws + WS_ASLOT);
    const bf16* H = (const bf16*)(a.ws + WS_H); bf16* XB = (bf16*)(a.ws + WS_XB);
    const int rbase = row0 + blk * RPB;
    for (int pr = wave; pr < RPB * 4; pr += NWAVES) { const int row = rbase + (pr >> 2), k = pr & 3; const int inf = ainfo[row * 4 + k]; const int slot = pbase[inf & 255] + (inf >> 8);
        if (lane == 0) aslot[row * 4 + k] = slot;
        const v4u w0 = *(const GAS v4u*)(H + (size_t)row * D + lane * 8), w1 = *(const GAS v4u*)(H + (size_t)row * D + 512 + lane * 8);
        *(GAS v4u*)(XB + (size_t)slot * D + lane * 8) = w0; *(GAS v4u*)(XB + (size_t)slot * D + 512 + lane * 8) = w1; }
}
__device__ __forceinline__ void moe_combine(const Args& a, int layer, int row0, int lane, int wave, int blk, int G) {
    float* xres = (float*)(a.ws + WS_X); bf16* H = (bf16*)(a.ws + WS_H); const bf16* YB = (const bf16*)(a.ws + WS_YB);
    const float* mod = (const float*)(a.ws + WS_MOD);
    const int* aslot = (const int*)(a.ws + WS_ASLOT); const float* agate = (const float*)(a.ws + WS_AGATE);
    const bool last = layer == DEPTH - 1;
    for (int row = row0 + blk * NWAVES + wave; row < T; row += G * NWAVES) {
        f32x4 acc[4];
#pragma unroll
        for (int j = 0; j < 4; ++j) acc[j] = (f32x4){0.f, 0.f, 0.f, 0.f};
#pragma unroll
        for (int k = 0; k < 4; ++k) { const int slot = aslot[row * 4 + k]; const float gk = agate[row * 4 + k];
#pragma unroll
            for (int j = 0; j < 4; ++j) { const v2u w = *(const GAS v2u*)(YB + (size_t)slot * D + 4 * lane + 256 * j); acc[j] += gk * (f32x4){blo(w.x), bhi(w.x), blo(w.y), bhi(w.y)}; } }
        const int mrw = modrow(row); const float* ml = mod + (size_t)(layer * 9 + mrw) * 6144;
        f32x4 v[4];
#pragma unroll
        for (int j = 0; j < 4; ++j) { const f32x4 x = *(const GAS f32x4*)(xres + (size_t)row * D + 4 * lane + 256 * j), g = *(const GAS f32x4*)(ml + 5120 + 4 * lane + 256 * j); v[j] = x + g * acc[j]; }
        if (!last) {
#pragma unroll
            for (int j = 0; j < 4; ++j) *(GAS f32x4*)(xres + (size_t)row * D + 4 * lane + 256 * j) = v[j];
            const float* mn = mod + (size_t)((layer + 1) * 9 + mrw) * 6144;
            row_norm_mod(v, a.in[I_N1G] + (layer + 1) * D, mn, mn + 1024, lane);
            store_row_bf16(H + (size_t)row * D, v, lane);
        } else {
            float s = 0.f;
#pragma unroll
            for (int j = 0; j < 4; ++j) s += (v[j].x * v[j].x + v[j].y * v[j].y) + (v[j].z * v[j].z + v[j].w * v[j].w);
            const float r = rsqrtf(wave_sum(s) * (1.f / D) + EPS);
#pragma unroll
            for (int j = 0; j < 4; ++j) { const f32x4 g = *(const GAS f32x4*)(a.in[I_FG] + 4 * lane + 256 * j); *(GAS f32x4*)(a.out + (size_t)(row - TCTX) * D + 4 * lane + 256 * j) = v[j] * r * g; }
        }
    }
}

__device__ __forceinline__ void grid_sync(const XcdBarrier& b0) { XcdBarrier b = b0; unsigned x = __builtin_amdgcn_readfirstlane(b0.x); asm volatile("" : "+s"(x)); b.x = x; xcd_barrier(b); }
#define PHASE_ENV() int tid = tid0; asm volatile("" : "+v"(tid)); const int lane = tid & 63, wave = __builtin_amdgcn_readfirstlane(tid >> 6); \
    const __attribute__((address_space(4))) Args* ap_ = (const __attribute__((address_space(4))) Args*)__builtin_amdgcn_kernarg_segment_ptr(); asm volatile("" : "+s"(ap_)); \
    const Args& a = *(const Args*)ap_; unsigned char* ws = a.ws; int layer = layer0; asm volatile("" : "+s"(layer)); (void)lane; (void)wave; (void)layer; (void)ws;
__global__ void __launch_bounds__(NTHR, 2) fwd_kernel(const Args a0) {
    extern __shared__ __attribute__((aligned(16))) unsigned char lds_raw[];
    LAS unsigned char* lds = (LAS unsigned char*)lds_raw;
    const int tid0 = threadIdx.x, blk = blockIdx.x, G = gridDim.x;
    volatile LAS unsigned* misc = (volatile LAS unsigned*)(lds + MISC_OFF);
    if (tid0 < 64) misc[tid0] = 0u;
    __syncthreads();
    XcdBarrier bar = xcd_barrier_post((unsigned*)a0.ws + CW_BAR, misc);
    int layer0 = 0;

    { PHASE_ENV(); p0_prologue(a, lds, tid, lane, wave, blk, G); }
    grid_sync(bar);
    { PHASE_ENV(); p0b_norm(a, lane, wave, blk, G); }
    grid_sync(bar);

    for (layer0 = 0; layer0 < DEPTH; ++layer0) {
        { PHASE_ENV(); pg8::Gemm g{(const bf16*)(ws + WS_H), (const bf16*)(ws + WS_WIN) + (size_t)layer * INW * D, T, INW, D}; pg8::StaticOrder S; S.init(T, INW, G, blk);
          EpiZ E{(bf16*)(ws + WS_Z), INW};
          pg8::gemm_phase<EpiZ, pg8::StaticOrder, true, true>(lds, g, S, E, tid); }
        grid_sync(bar);
        { PHASE_ENV(); for (int u = blk; u < 576; u += G) prep_unit(a, u, lds, tid); }
        { PHASE_ENV(); for (int u = blk; u < 288; u += G) conv_unit(a, layer, u, lds, tid, lane, wave); }
        grid_sync(bar);
        { PHASE_ENV(); for (int u = blk; u < 256; u += G) ret_state_unit(a, u, lds, tid, lane, wave); }
        { PHASE_ENV(); for (int u = blk; u < 864; u += G) ssm_gemm1_unit(a, layer, u, lds, tid, lane, wave); }
        grid_sync(bar);
        { PHASE_ENV(); for (int u = blk; u < 32; u += G) ssm_scan_unit(a, layer, u, tid); }
        { PHASE_ENV(); for (int u = blk; u < 576; u += G) ret_out_unit(a, u, lds, tid, lane, wave); }
        grid_sync(bar);
        { PHASE_ENV(); for (int u = blk; u < 576; u += G) ssm_gemm2_unit(a, layer, u, lds, tid, lane, wave); }
        grid_sync(bar);
        { PHASE_ENV(); int kk_ = 256; asm volatile("" : "+s"(kk_)); pg8::Gemm g{(const bf16*)(ws + WS_SACT), (const bf16*)(ws + WS_WGLU) + (size_t)layer * 2048 * 256, T, 2048, kk_}; pg8::StaticOrder S; S.init(T, 2048, G, blk);
          EpiGlu E{(bf16*)(ws + WS_M1), (const bf16*)(ws + WS_Z), a.in[I_GLUB] + layer * 2048};
          pg8::gemm_phase<EpiGlu, pg8::StaticOrder, true, true>(lds, g, S, E, tid); }
        { PHASE_ENV(); int kk_ = 256; asm volatile("" : "+s"(kk_)); pg8::Gemm g{(const bf16*)(ws + WS_CACT), (const bf16*)(ws + WS_WPW) + (size_t)layer * 1024 * 256, T, 1024, kk_}; pg8::StaticOrder S; S.init(T, 1024, G, blk);
          EpiPw E{(bf16*)(ws + WS_M2), (const bf16*)(ws + WS_Z), a.in[I_PWB] + layer * 1024};
          pg8::gemm_phase<EpiPw, pg8::StaticOrder, true, true>(lds, g, S, E, tid); }
        grid_sync(bar);
        { PHASE_ENV(); pg8::Gemm g{(const bf16*)(ws + WS_RACT), (const bf16*)(ws + WS_WO) + (size_t)layer * 1024 * 512, T, 1024, 512}; pg8::StaticOrder S; S.init(T, 1024, G, blk);
          EpiWo E{(bf16*)(ws + WS_M1), (const bf16*)(ws + WS_M2), (const bf16*)(ws + WS_Z)};
          pg8::gemm_phase<EpiWo, pg8::StaticOrder, true, true>(lds, g, S, E, tid); }
        grid_sync(bar);
        { PHASE_ENV(); pg8::Gemm g{(const bf16*)(ws + WS_M1), (const bf16*)(ws + WS_WOUT) + (size_t)layer * 1024 * 1024, T, 1024, 1024}; pg8::StaticOrder S; S.init(T, 1024, G, blk);
          EpiOut E{(float*)(ws + WS_X), (const float*)(ws + WS_MOD) + (size_t)layer * 9 * 6144};
          pg8::gemm_phase<EpiOut, pg8::StaticOrder, true, true>(lds, g, S, E, tid); }
        grid_sync(bar);
        { PHASE_ENV(); const int row0 = layer == DEPTH - 1 ? TCTX : 0, RPB = (T - row0) / 256; moe_route(a, layer, row0, RPB, lds, tid, lane, wave, blk); }
        grid_sync(bar);
        { PHASE_ENV(); const int row0 = layer == DEPTH - 1 ? TCTX : 0, RPB = (T - row0) / 256; moe_gather(a, row0, RPB, lds, tid, lane, wave, blk, G); }
        grid_sync(bar);
        { PHASE_ENV(); pg8::Gemm g{(const bf16*)(ws + WS_XB), (const bf16*)(ws + WS_WGU) + (size_t)layer * NE * 2048 * 1024, XB_ROWS, NE * 2048, D}; MoeOrder S; S.init((const int*)ws + CW_MOE, 8, G, blk);
          EpiGu E{(bf16*)(ws + WS_ACT), a.in[I_GUB] + (size_t)layer * NE * 2048};
          pg8::gemm_phase<EpiGu, MoeOrder, true, true>(lds, g, S, E, tid); }
        grid_sync(bar);
        { PHASE_ENV(); pg8::Gemm g{(const bf16*)(ws + WS_ACT), (const bf16*)(ws + WS_WD) + (size_t)layer * NE * 1024 * 1024, XB_ROWS, NE * 1024, D}; MoeOrder S; S.init((const int*)ws + CW_MOE, 4, G, blk);
          EpiDown E{(bf16*)(ws + WS_YB), a.in[I_DB] + (size_t)layer * NE * 1024};
          pg8::gemm_phase<EpiDown, MoeOrder, true, true>(lds, g, S, E, tid); }
        grid_sync(bar);
        { PHASE_ENV(); const int row0 = layer == DEPTH - 1 ? TCTX : 0; moe_combine(a, layer, row0, lane, wave, blk, G); }
        grid_sync(bar);
    }
}

extern "C" void kernel_launch(void* const* d_in, const int* in_sizes, int n_in, void* d_out, int out_size, void* d_ws, size_t ws_size, hipStream_t stream) {
    static int grid = 0;
    if (grid == 0) {
        if (n_in != 34 || out_size != NB * LAT * D || ws_size < WS_END) { fprintf(stderr, "kernel_launch: unexpected shapes (n_in %d, out %d, ws %zu, need %zu); nothing launched\n", n_in, out_size, ws_size, (size_t)WS_END); grid = -1; return; }
        int dev = 0, cus = 0, per_cu = 0;
        if (hipGetDevice(&dev) != hipSuccess || hipDeviceGetAttribute(&cus, hipDeviceAttributeMultiprocessorCount, dev) != hipSuccess) { grid = -1; return; }
        if (hipFuncSetAttribute((const void*)fwd_kernel, hipFuncAttributeMaxDynamicSharedMemorySize, LDS_BYTES) != hipSuccess) { fprintf(stderr, "kernel_launch: hipFuncSetAttribute failed\n"); grid = -1; return; }
        if (hipOccupancyMaxActiveBlocksPerMultiprocessor(&per_cu, (const void*)fwd_kernel, NTHR, LDS_BYTES) != hipSuccess || per_cu < 1) fprintf(stderr, "kernel_launch: occupancy query reports %d\n", per_cu);
        (void)hipGetLastError();
        grid = cus < 256 ? cus : 256;
    }
    if (grid < 0) return;
    if (hipMemsetAsync((char*)d_ws + WS_CTL, 0, CTL_BYTES, stream) != hipSuccess) return;
    Args a{};
    for (int i = 0; i < 34; ++i) a.in[i] = (const float*)d_in[i];
    a.out = (float*)d_out; a.ws = (unsigned char*)d_ws;
    hipLaunchKernelGGL(fwd_kernel, dim3(grid), dim3(NTHR), LDS_BYTES, stream, a);
}
```

```cpp
#include <hip/hip_runtime.h>
#include <cstdio>
#include <cstdint>

#ifndef DBG
#define DBG 0
#endif
namespace pg8 {
#define PG8_LAS __attribute__((address_space(3)))
typedef unsigned short bf16_t;
typedef short bf16x8 __attribute__((ext_vector_type(8)));
typedef float f32x4 __attribute__((ext_vector_type(4)));
typedef unsigned u32x4 __attribute__((ext_vector_type(4)));
constexpr int BM = 256, BK = 64, HALF = 128, HTB = HALF * BK * 2  , STAGE_BYTES = 8 * HTB, NXCD = 8, WGM = 8;

__host__ __device__ __forceinline__ int lds_byte(int r, int c) { const int st = (r >> 4) * 2 + (c >> 5), rr = r & 15, cc = c & 31, ob = rr * 64 + cc * 2; return st * 1024 + (ob ^ (((ob >> 9) & 1) << 5)); }
__host__ __device__ __forceinline__ void stage_rc(int b, int& R, int& C) { const int st = b / 1024, sb = b % 1024, swz = sb ^ (((sb >> 9) & 1) << 5); R = (st >> 1) * 16 + swz / 64; C = (st & 1) * 32 + (swz % 64) / 2; }
__host__ __device__ __forceinline__ int perm32(int rho) { const int n = rho >> 4, i = rho & 15; return 8 * (i >> 2) + 4 * n + (i & 3); }

struct Unit { int pm, pn; };
struct Gemm { const bf16_t* A; const bf16_t* Bt; int M, N, K; };

struct StaticOrder {
    int nM, nN, nwg, G, c;
    __host__ __device__ void init(int M, int N, int G_, int c_) { nM = M / BM; nN = N / BM; nwg = nM * nN; G = G_; c = c_; }
    __host__ __device__ bool next(int i, Unit& u) const {
        const long L = (long)i * G + c; if (L >= nwg) return false;
        int wgid = (int)L; { const int q = nwg / NXCD, r = nwg % NXCD, xcd = wgid % NXCD, off = wgid / NXCD; wgid = (xcd < r ? xcd * (q + 1) : r * (q + 1) + (xcd - r) * q) + off; }
        const int nig = WGM * nN, gid = wgid / nig, fm = gid * WGM, gsz = (nM - fm) < WGM ? (nM - fm) : WGM;
        u.pm = fm + ((wgid % nig) % gsz); u.pn = (wgid % nig) / gsz; return true;
    }
    __device__ __forceinline__ void a_ready(const Unit&) const {}
    __device__ __forceinline__ void done(const Unit&) const {}
};

template <class Epi, class Sched, bool ALIGN_EPI = false, bool SP2 = false>
__device__ __forceinline__ void gemm_phase(PG8_LAS unsigned char* lds, const Gemm g, const Sched& S, const Epi& E, const int tid) {
    const int wid = __builtin_amdgcn_readfirstlane(tid >> 6), lane = tid & 63, wr = wid >> 2, wc = wid & 3, fr = lane & 15, fq = lane >> 4;
    const int K = g.K, nt = K / BK;
    unsigned voffA[2], voffB[2];
#pragma unroll
    for (int i = 0; i < 2; ++i) { int R, C; stage_rc(tid * 16 + i * 8192, R, C); const int Rb = Epi::PERM ? ((R & ~31) + perm32(R & 31)) : R;
        voffA[i] = (unsigned)(R * K + C) * 2u; voffB[i] = (unsigned)(Rb * K + C) * 2u; }
    const size_t kstep = (size_t)(BK * 2);
    const size_t hstep = (size_t)HALF * K * 2;
    const size_t tstep = 2 * hstep;
    const unsigned ldsw = (unsigned)wid * 1024u;
    const int aoff = lds_byte(wr * 64 + fr, fq * 8), boff = lds_byte(wc * 32 + fr, fq * 8);
#define PG8_SA(b, h) (((b) * 2 + (h)) * HTB)
#define PG8_SB(b, h) ((4 + (b) * 2 + (h)) * HTB)
#define PG8_STAGE(bufoff, gbase, voff) do { _Pragma("unroll") for (int _i = 0; _i < 2; ++_i) \
        __builtin_amdgcn_global_load_lds((const unsigned*)((const char*)(gbase) + (voff)[_i]), (PG8_LAS unsigned*)(lds + (bufoff) + ldsw + _i * 8192), 16, 0, 0); } while (0)
#define PG8_LDA(dst, b, h) do { _Pragma("unroll") for (int m = 0; m < 4; ++m) _Pragma("unroll") for (int k = 0; k < 2; ++k) dst[m][k] = *(const PG8_LAS bf16x8*)(lds + PG8_SA(b, h) + aoff + m * 2048 + k * 1024); } while (0)
#define PG8_LDB(dst, b, h) do { _Pragma("unroll") for (int n = 0; n < 2; ++n) _Pragma("unroll") for (int k = 0; k < 2; ++k) dst[n][k] = *(const PG8_LAS bf16x8*)(lds + PG8_SB(b, h) + boff + n * 2048 + k * 1024); } while (0)
#define PG8_MMA(ai, bj, At, Bt) do { __builtin_amdgcn_s_setprio(1); _Pragma("unroll") for (int m = 0; m < 4; ++m) _Pragma("unroll") for (int n = 0; n < 2; ++n) _Pragma("unroll") for (int k = 0; k < 2; ++k) \
        acc[ai][bj][m][n] = __builtin_amdgcn_mfma_f32_16x16x32_bf16(Bt[n][k], At[m][k], acc[ai][bj][m][n], 0, 0, 0); __builtin_amdgcn_s_setprio(0); } while (0)
#define PG8_WAIT_V(n) asm volatile("s_waitcnt vmcnt(" #n ")" ::: "memory")
#define PG8_WAIT_L(n) asm volatile("s_waitcnt lgkmcnt(" #n ")" ::: "memory")
#define PG8_BAR __builtin_amdgcn_s_barrier()
#define PG8_SCHED __builtin_amdgcn_sched_barrier(0)
    Unit cur, nxt; int ui = 0;
    if (!S.next(0, cur)) return;
    f32x4 acc[2][2][4][2];
#pragma unroll
    for (int a = 0; a < 2; ++a)
#pragma unroll
        for (int b = 0; b < 2; ++b)
#pragma unroll
            for (int m = 0; m < 4; ++m)
#pragma unroll
                for (int n = 0; n < 2; ++n) acc[a][b][m][n] = (f32x4){0.f, 0.f, 0.f, 0.f};
    bf16x8 At[4][2], B0[2][2], B1[2][2];
    const char* cA = (const char*)g.A + (size_t)cur.pm * tstep; const char* cB = (const char*)g.Bt + (size_t)cur.pn * tstep;
    S.a_ready(cur);
    if constexpr (SP2) {
        PG8_STAGE(PG8_SB(0, 0), cB, voffB); PG8_STAGE(PG8_SB(0, 1), cB + hstep, voffB); PG8_STAGE(PG8_SA(0, 0), cA, voffA); PG8_STAGE(PG8_SA(0, 1), cA + hstep, voffA);
        if (wr == 1) PG8_BAR;
        PG8_WAIT_V(2); PG8_BAR;
        PG8_STAGE(PG8_SB(1, 0), cB + kstep, voffB); PG8_STAGE(PG8_SA(1, 0), cA + kstep, voffA); PG8_STAGE(PG8_SB(1, 1), cB + hstep + kstep, voffB);
        PG8_WAIT_V(6); PG8_BAR;
    } else {
        PG8_STAGE(PG8_SB(0, 0), cB, voffB); PG8_STAGE(PG8_SA(0, 0), cA, voffA); PG8_STAGE(PG8_SB(0, 1), cB + hstep, voffB); PG8_STAGE(PG8_SA(0, 1), cA + hstep, voffA);
        if (wr == 1) PG8_BAR;
        PG8_WAIT_V(4); PG8_BAR;
        PG8_STAGE(PG8_SB(1, 0), cB + kstep, voffB); PG8_STAGE(PG8_SA(1, 0), cA + kstep, voffA); PG8_STAGE(PG8_SB(1, 1), cB + hstep + kstep, voffB);
        PG8_WAIT_V(6); PG8_BAR;
    }
    for (;;) {
        const bool has_next = S.next(ui + 1, nxt);
        const char* nA = has_next ? (const char*)g.A + (size_t)nxt.pm * tstep : cA; const char* nB = has_next ? (const char*)g.Bt + (size_t)nxt.pn * tstep : cB;
        for (int t = 0; t < nt; t += 2) {
            const bool last = (t == nt - 2);
            const char* a1 = cA + (size_t)(t + 1) * kstep;
            const char* a2 = last ? nA : cA + (size_t)(t + 2) * kstep; const char* b2 = last ? nB : cB + (size_t)(t + 2) * kstep;
            const char* a3 = a2 + kstep; const char* b3 = b2 + kstep;
            if (last && has_next) S.a_ready(nxt);
            if constexpr (SP2) {
            PG8_LDB(B0, 0, 0); PG8_LDB(B1, 0, 1); PG8_SCHED; PG8_LDA(At, 0, 0); PG8_STAGE(PG8_SA(1, 1), a1 + hstep, voffA);
            PG8_WAIT_V(8); PG8_WAIT_L(0); PG8_BAR; PG8_MMA(0, 0, At, B0); PG8_MMA(0, 1, At, B1); PG8_BAR; PG8_SCHED;
            PG8_LDA(At, 0, 1); PG8_STAGE(PG8_SB(0, 0), b2, voffB); PG8_STAGE(PG8_SB(0, 1), b2 + hstep, voffB); PG8_STAGE(PG8_SA(0, 0), a2, voffA);
            PG8_WAIT_V(8); PG8_WAIT_L(0); PG8_BAR; PG8_MMA(1, 0, At, B0); PG8_MMA(1, 1, At, B1); PG8_BAR; PG8_SCHED;
            PG8_LDB(B0, 1, 0); PG8_LDB(B1, 1, 1); PG8_SCHED; PG8_LDA(At, 1, 0); PG8_STAGE(PG8_SA(0, 1), a2 + hstep, voffA);
            PG8_WAIT_V(8); PG8_WAIT_L(0); PG8_BAR; PG8_MMA(0, 0, At, B0); PG8_MMA(0, 1, At, B1); PG8_BAR; PG8_SCHED;
            PG8_LDA(At, 1, 1); PG8_STAGE(PG8_SB(1, 0), b3, voffB); PG8_STAGE(PG8_SB(1, 1), b3 + hstep, voffB); PG8_STAGE(PG8_SA(1, 0), a3, voffA);
            PG8_WAIT_V(8); PG8_WAIT_L(0); PG8_BAR; PG8_MMA(1, 0, At, B0); PG8_MMA(1, 1, At, B1); PG8_BAR; PG8_SCHED;
            } else {
            PG8_LDB(B0, 0, 0); PG8_SCHED; PG8_LDA(At, 0, 0); PG8_STAGE(PG8_SA(1, 1), a1 + hstep, voffA);
            PG8_WAIT_L(8); PG8_BAR; PG8_WAIT_L(0); PG8_MMA(0, 0, At, B0); PG8_BAR; PG8_SCHED;
            PG8_LDB(B1, 0, 1); PG8_STAGE(PG8_SB(0, 0), b2, voffB);
            PG8_BAR; PG8_WAIT_L(0); PG8_MMA(0, 1, At, B1); PG8_BAR;
            PG8_LDA(At, 0, 1); PG8_STAGE(PG8_SA(0, 0), a2, voffA);
            PG8_BAR; PG8_WAIT_L(0); PG8_MMA(1, 0, At, B0); PG8_BAR; PG8_SCHED;
            PG8_STAGE(PG8_SB(0, 1), b2 + hstep, voffB);
            PG8_WAIT_V(6); PG8_BAR; PG8_MMA(1, 1, At, B1); PG8_BAR;
            PG8_LDB(B0, 1, 0); PG8_SCHED; PG8_LDA(At, 1, 0); PG8_STAGE(PG8_SA(0, 1), a2 + hstep, voffA);
            PG8_WAIT_L(8); PG8_BAR; PG8_WAIT_L(0); PG8_MMA(0, 0, At, B0); PG8_BAR; PG8_SCHED;
            PG8_LDB(B1, 1, 1); PG8_STAGE(PG8_SB(1, 0), b3, voffB);
            PG8_BAR; PG8_WAIT_L(0); PG8_MMA(0, 1, At, B1); PG8_BAR;
            PG8_LDA(At, 1, 1); PG8_STAGE(PG8_SA(1, 0), a3, voffA);
            PG8_BAR; PG8_WAIT_L(0); PG8_MMA(1, 0, At, B0); PG8_BAR; PG8_SCHED;
            PG8_STAGE(PG8_SB(1, 1), b3 + hstep, voffB);
            PG8_WAIT_V(6); PG8_BAR; PG8_MMA(1, 1, At, B1); PG8_BAR;
            }
        }
        if constexpr (ALIGN_EPI) { if (wr == 0) PG8_BAR; }
        if constexpr (!Epi::AFTER_DRAIN) { E(acc, cur, wr, wc, fr, fq); S.done(cur); }
        if (!has_next) break;
#pragma unroll
        for (int a = 0; a < 2; ++a)
#pragma unroll
            for (int b = 0; b < 2; ++b)
#pragma unroll
                for (int m = 0; m < 4; ++m)
#pragma unroll
                    for (int n = 0; n < 2; ++n) acc[a][b][m][n] = (f32x4){0.f, 0.f, 0.f, 0.f};
        cur = nxt; cA = nA; cB = nB; ++ui;
        if constexpr (ALIGN_EPI) { if (wr == 1) PG8_BAR; }
    }
    PG8_WAIT_V(0);
    if constexpr (!ALIGN_EPI) { if (wr == 0) PG8_BAR; }
    PG8_BAR;
    if constexpr (Epi::AFTER_DRAIN) { E.fused(acc, cur, wr, wc, fr, fq, lds, wid, lane); S.done(cur); }
#undef PG8_SA
#undef PG8_SB
#undef PG8_STAGE
#undef PG8_LDA
#undef PG8_LDB
#undef PG8_MMA
#undef PG8_WAIT_V
#undef PG8_WAIT_L
#undef PG8_BAR
#undef PG8_SCHED
}
}

#define XB_TMO      128
#define XB_XCNT(j)  (256  + 64 * (j))
#define XB_XSUB(j)  (1280 + 64 * (j))
#define XB_XGEN(j)  (2304 + 64 * (j))
#define XB_TOP      3328
#define XB_TOPGEN   3392
#define XCD_BAR_WORDS 3456
#define XB_SPIN_CAP (1u << 18)
#define LAS __attribute__((address_space(3)))

__device__ __forceinline__ unsigned xb_ld(unsigned* p)              { return __hip_atomic_load(p, __ATOMIC_RELAXED, __HIP_MEMORY_SCOPE_AGENT); }
__device__ __forceinline__ unsigned xb_add(unsigned* p, unsigned v) { return __hip_atomic_fetch_add(p, v, __ATOMIC_RELAXED, __HIP_MEMORY_SCOPE_AGENT); }
__device__ __forceinline__ unsigned xb_xcc_id() { return (unsigned)__builtin_amdgcn_s_getreg((3 << 11) | 20) & 0xFu; }
#define XB_SPIN(cond, bar) do { unsigned _sp = 0; while (cond) { __builtin_amdgcn_s_sleep(1); \
    if ((++_sp & 255u) == 0u) { if (xb_ld(&(bar)[XB_TMO])) break; if (_sp > XB_SPIN_CAP) { atomicAdd(&(bar)[XB_TMO], 1u); break; } } } } while (0)

struct XcdBarrier {
    unsigned* bar; unsigned x;
    volatile LAS unsigned* st;
};

__device__ __forceinline__ XcdBarrier xcd_barrier_post(unsigned* bar, volatile LAS unsigned* st) {
    XcdBarrier b; b.bar = bar; b.x = xb_xcc_id(); b.st = st;
    if (threadIdx.x == 0) (void)xb_add(&bar[XB_XCNT(b.x)], 1u);
    return b;
}
__device__ __forceinline__ void xcd_barrier_complete(unsigned* bar, unsigned x, unsigned& nloc, unsigned& nx) {
    const unsigned G = gridDim.x * gridDim.y * gridDim.z;
    unsigned sum, cnt, mine, sp = 0u;
    for (;;) {
        sum = 0u; cnt = 0u; mine = 0u;
#pragma unroll
        for (unsigned j = 0; j < 16; ++j) { const unsigned c = xb_ld(&bar[XB_XCNT(j)]); sum += c; cnt += (c > 0u) ? 1u : 0u; mine = (j == x) ? c : mine; }
        if (sum == G) break;
        __builtin_amdgcn_s_sleep(1);
        if ((++sp & 255u) == 0u) { if (xb_ld(&bar[XB_TMO])) break; if (sp > XB_SPIN_CAP) { atomicAdd(&bar[XB_TMO], 1u); break; } }
    }
    nloc = mine > 0u ? mine : 1u; nx = cnt > 0u ? cnt : 1u;
}

__device__ __forceinline__ void xcd_barrier(const XcdBarrier& b) {
    asm volatile("s_waitcnt vmcnt(0)" ::: "memory");
    __syncthreads();
    if (threadIdx.x == 0) {
        unsigned* bar = b.bar;
        __builtin_amdgcn_s_waitcnt(0);
        unsigned nloc = b.st[0], nx = b.st[1];
        if (nloc == 0u) { xcd_barrier_complete(bar, b.x, nloc, nx); b.st[0] = nloc; b.st[1] = nx; }
        const unsigned old = xb_add(&bar[XB_XSUB(b.x)], 1u);
        const unsigned gen = old / nloc;
        if (old + 1u == (gen + 1u) * nloc) {
            __builtin_amdgcn_fence(__ATOMIC_RELEASE, "agent");
            asm volatile("s_waitcnt vmcnt(0)" ::: "memory");
            const unsigned og = xb_add(&bar[XB_TOP], 1u);
            const unsigned tg = og / nx;
            if (og + 1u == (tg + 1u) * nx) xb_add(&bar[XB_TOPGEN], 1u);
            else XB_SPIN(xb_ld(&bar[XB_TOPGEN]) == tg, bar);
            __builtin_amdgcn_fence(__ATOMIC_ACQUIRE, "agent");
            xb_add(&bar[XB_XGEN(b.x)], 1u);
            asm volatile("s_waitcnt vmcnt(0)" ::: "memory");
        } else {
            XB_SPIN(xb_ld(&bar[XB_XGEN(b.x)]) == gen, bar);
            __builtin_amdgcn_fence(__ATOMIC_ACQUIRE, "agent");
            asm volatile("s_waitcnt vmcnt(0)" ::: "memory");
        }
    }
    __syncthreads();
}


#define GAS __attribute__((address_space(1)))
typedef unsigned short bf16;
typedef unsigned v4u __attribute__((ext_vector_type(4)));
typedef unsigned v2u __attribute__((ext_vector_type(2)));
typedef float f32x4 __attribute__((ext_vector_type(4)));
typedef float f32x2 __attribute__((ext_vector_type(2)));
typedef short bf16x8 __attribute__((ext_vector_type(8)));

constexpr int D = 1024, NB = 8, LAT = 2048, CTXL = 256, DEPTH = 4, SEQC = LAT + CTXL;
constexpr int T = NB * SEQC, TCTX = NB * CTXL;
constexpr int INW = 5888;
constexpr int ZU = 0, ZCA = 256, ZCG = 512, ZQ = 768, ZK = 1280, ZV = 1792, ZG = 2304, ZGS = 2816, ZGC = 3840, ZGR = 4864;
constexpr int NE = 32;
constexpr int XB_TILES = 328, XB_ROWS = XB_TILES * 256;
constexpr int NCH = 72;
constexpr int SROWS = NB * NCH;
constexpr int NWAVES = 8, NTHR = 512;
constexpr float EPS = 1e-6f;

constexpr size_t al4k(size_t x) { return (x + 4095) & ~(size_t)4095; }
constexpr size_t WS_CTL = 0, CTL_BYTES = 1u << 20;
constexpr size_t WS_MOD = WS_CTL + CTL_BYTES,        SZ_MOD = al4k((size_t)DEPTH * 9 * 6144 * 4);
constexpr size_t WS_LAMC = WS_MOD + SZ_MOD,          SZ_LAMC = al4k((size_t)DEPTH * 2 * 16 * 64 * 2 * 4);
constexpr size_t WS_WIN = WS_LAMC + SZ_LAMC,         SZ_WIN = al4k((size_t)DEPTH * INW * D * 2);
constexpr size_t WS_WGLU = WS_WIN + SZ_WIN,          SZ_WGLU = al4k((size_t)DEPTH * 2048 * 256 * 2);
constexpr size_t WS_WPW = WS_WGLU + SZ_WGLU,         SZ_WPW = al4k((size_t)DEPTH * 1024 * 256 * 2);
constexpr size_t WS_WO = WS_WPW + SZ_WPW,            SZ_WO = al4k((size_t)DEPTH * 1024 * 512 * 2);
constexpr size_t WS_WOUT = WS_WO + SZ_WO,            SZ_WOUT = al4k((size_t)DEPTH * 1024 * 1024 * 2);
constexpr size_t WS_WGU = WS_WOUT + SZ_WOUT,         SZ_WGU = al4k((size_t)DEPTH * NE * 2048 * 1024 * 2);
constexpr size_t WS_WD = WS_WGU + SZ_WGU,            SZ_WD = al4k((size_t)DEPTH * NE * 1024 * 1024 * 2);
constexpr size_t WS_SW1 = WS_WD + SZ_WD,             SZ_SW1 = al4k((size_t)DEPTH * 16 * 768 * 512 * 2);
constexpr size_t WS_SW2 = WS_SW1 + SZ_SW1,           SZ_SW2 = al4k((size_t)DEPTH * 16 * 512 * 256 * 2);
constexpr size_t WS_X = WS_SW2 + SZ_SW2,             SZ_X = al4k((size_t)T * D * 4);
constexpr size_t WS_H = WS_X + SZ_X,                 SZ_H = al4k((size_t)T * D * 2);
constexpr size_t WS_Z = WS_H + SZ_H,                 SZ_Z = al4k((size_t)T * INW * 2);
constexpr size_t WS_UG = WS_Z + SZ_Z,                SZ_UG = al4k((size_t)T * 256 * 2);
constexpr size_t SZ_HD = al4k((size_t)T * 512 * 2);
constexpr size_t WS_QR = WS_UG + SZ_UG, WS_KR = WS_QR + SZ_HD, WS_KTF = WS_KR + SZ_HD, WS_KTB = WS_KTF + SZ_HD, WS_VT = WS_KTB + SZ_HD;
constexpr size_t WS_CACT = WS_VT + SZ_HD,            SZ_CACT = al4k((size_t)T * 256 * 2);
constexpr size_t WS_Y1 = WS_CACT + SZ_CACT,          SZ_Y1 = al4k((size_t)16 * SROWS * 512 * 4);
constexpr size_t WS_ZC = WS_Y1 + SZ_Y1,              SZ_ZC = al4k((size_t)16 * SROWS * 256 * 4);
constexpr size_t WS_SIN = WS_ZC + SZ_ZC,             SZ_SIN = al4k((size_t)16 * SROWS * 256 * 2);
constexpr size_t WS_SPREV = WS_SIN + SZ_SIN,         SZ_SPREV = al4k((size_t)NB * 4 * 2 * 18 * 128 * 128 * 2);
constexpr size_t WS_SACT = WS_SPREV + SZ_SPREV,      SZ_SACT = al4k((size_t)T * 256 * 2);
constexpr size_t WS_RACT = WS_SACT + SZ_SACT,        SZ_RACT = al4k((size_t)T * 512 * 2);
constexpr size_t WS_M1 = WS_RACT + SZ_RACT,          SZ_M = al4k((size_t)T * D * 2);
constexpr size_t WS_M2 = WS_M1 + SZ_M;
constexpr size_t WS_XB = WS_M2 + SZ_M,               SZ_XB = al4k((size_t)XB_ROWS * D * 2);
constexpr size_t WS_ACT = WS_XB + SZ_XB, WS_YB = WS_ACT + SZ_XB;
constexpr size_t WS_AINFO = WS_YB + SZ_XB,           SZ_AI = al4k((size_t)T * 4 * 4);
constexpr size_t WS_AGATE = WS_AINFO + SZ_AI, WS_ASLOT = WS_AGATE + SZ_AI;
constexpr size_t WS_M3 = WS_ASLOT + SZ_AI;
constexpr size_t WS_DUMMY = WS_M3 + SZ_M;
constexpr size_t WS_END = WS_DUMMY + SZ_X;

constexpr int CW_BAR = 4096;
constexpr int CW_MOE = 16384;
constexpr int CW_HIST = 32768;
constexpr int CW_DBG = 65536;

constexpr int LDS_BYTES = 155648;
constexpr int MISC_OFF = LDS_BYTES - 256;

#define LDS_WAIT() asm volatile("s_waitcnt lgkmcnt(0)" ::: "memory")
#define VM_WAIT() asm volatile("s_waitcnt vmcnt(0)" ::: "memory")

__device__ __forceinline__ float bf2f(unsigned v) { return __uint_as_float(v << 16); }
__device__ __forceinline__ unsigned f2bf(float f) { unsigned u = __float_as_uint(f); return (u + 0x7fffu + ((u >> 16) & 1u)) >> 16; }
__device__ __forceinline__ unsigned pk2(float lo, float hi) { return f2bf(lo) | (f2bf(hi) << 16); }
__device__ __forceinline__ float blo(unsigned w) { return __uint_as_float(w << 16); }
__device__ __forceinline__ float bhi(unsigned w) { return __uint_as_float(w & 0xffff0000u); }
__device__ __forceinline__ float sigm(float x) { return 1.f / (1.f + __expf(-x)); }
__device__ __forceinline__ float silu_(float x) { return x / (1.f + __expf(-x)); }
__device__ __forceinline__ float gelu_tanh(float x) { const float z = 0.7978845608f * (x + 0.044715f * x * x * x); const float e = __expf(2.f * z); const float th = 1.f - 2.f / (e + 1.f); return 0.5f * x * (1.f + th); }
__device__ __forceinline__ float wave_sum(float v) {
#pragma unroll
    for (int o = 1; o < 64; o <<= 1) v += __shfl_xor(v, o);
    return v;
}
__device__ __forceinline__ void unpack8(const v4u w, float (&f)[8]) { f[0] = blo(w.x); f[1] = bhi(w.x); f[2] = blo(w.y); f[3] = bhi(w.y); f[4] = blo(w.z); f[5] = bhi(w.z); f[6] = blo(w.w); f[7] = bhi(w.w); }
__device__ __forceinline__ v4u pack8(const float (&f)[8]) { v4u w; w.x = pk2(f[0], f[1]); w.y = pk2(f[2], f[3]); w.z = pk2(f[4], f[5]); w.w = pk2(f[6], f[7]); return w; }
__device__ __forceinline__ int tokrow(int b, int n) { return n < CTXL ? b * CTXL + n : TCTX + b * LAT + (n - CTXL); }
__device__ __forceinline__ int modrow(int row) { return row < TCTX ? 8 : (row - TCTX) >> 11; }
__device__ __forceinline__ float lg2gamma(int hh) { return log1pf(-exp2f(-5.f - (float)hh)) * 1.4426950408889634f; }

template <int ROWS, int KC> __device__ __forceinline__ void bg_stage(LAS unsigned char* dst, const bf16* src, size_t ld, int tid) {
    constexpr int CPR = KC / 8, LSTR = KC * 2 + 16, N = ROWS * CPR / NTHR;
    static_assert(ROWS * CPR % NTHR == 0, "bg_stage");
    v4u v[N];
#pragma unroll
    for (int q = 0; q < N; ++q) { const int i = tid + q * NTHR, r = i / CPR, c = i % CPR; v[q] = *(const GAS v4u*)(src + (size_t)r * ld + c * 8); }
#pragma unroll
    for (int q = 0; q < N; ++q) { const int i = tid + q * NTHR, r = i / CPR, c = i % CPR; *(LAS v4u*)(dst + r * LSTR + c * 16) = v[q]; }
}
template <int NT, int KC> __device__ __forceinline__ void bg_mma(f32x4 (&acc)[NT], const LAS unsigned char* As, const LAS unsigned char* Bs, int arow0, int bcol0, int fr, int fq) {
    constexpr int LSTR = KC * 2 + 16;
    const LAS unsigned char* ap = As + (arow0 + fr) * LSTR + fq * 16;
    const LAS unsigned char* bp = Bs + (bcol0 + fr) * LSTR + fq * 16;
#pragma unroll
    for (int ks = 0; ks < KC / 32; ++ks) {
        const bf16x8 a = *(const LAS bf16x8*)(ap + ks * 64);
#pragma unroll
        for (int t = 0; t < NT; ++t) { const bf16x8 b = *(const LAS bf16x8*)(bp + t * 16 * LSTR + ks * 64); acc[t] = __builtin_amdgcn_mfma_f32_16x16x32_bf16(a, b, acc[t], 0, 0, 0); }
    }
}

struct Args { const float* in[34]; float* out; unsigned char* ws; };
enum { I_X = 0, I_C, I_CTX, I_CCTX, I_ADAW, I_ADAB, I_N1G, I_WIN, I_LRE, I_LIM, I_LDT, I_BRE, I_BIM, I_CRE, I_CIM, I_SD, I_GLUW, I_GLUB, I_DWW, I_DWB, I_LNG, I_LNB, I_PWW, I_PWB,
       I_WO, I_WOUT, I_N2G, I_RW, I_RB, I_GUW, I_GUB, I_DW, I_DB, I_FG };

__device__ __forceinline__ void transpose_item(const float* W, int K, int N, bf16* WT, int n0, int drow0, int k0, LAS float* scr, int lane) {
    float v[32];
    const float* wp = W + (size_t)(k0 + (lane >> 5)) * N + n0 + (lane & 31);
#pragma unroll
    for (int i = 0; i < 32; ++i) v[i] = __builtin_nontemporal_load(wp + (size_t)(2 * i) * N);
#pragma unroll
    for (int i = 0; i < 32; ++i) scr[(2 * i + (lane >> 5)) * 33 + (lane & 31)] = v[i];
    LDS_WAIT(); asm volatile("" ::: "memory");
    const int c = lane & 7;
#pragma unroll
    for (int j = 0; j < 4; ++j) { const int n = (lane >> 3) + 8 * j; const LAS float* s = scr + (8 * c) * 33 + n;
        v4u o; o.x = pk2(s[0 * 33], s[1 * 33]); o.y = pk2(s[2 * 33], s[3 * 33]); o.z = pk2(s[4 * 33], s[5 * 33]); o.w = pk2(s[6 * 33], s[7 * 33]);
        *(GAS v4u*)(WT + (size_t)(drow0 + n) * K + k0 + 8 * c) = o; }
    LDS_WAIT(); asm volatile("" ::: "memory");
}
__device__ __forceinline__ int ilv128(int n0, int half) { const int q = n0 < half ? n0 : n0 - half; return (q >> 7) * 256 + (n0 < half ? 0 : 128) + (q & 127); }

constexpr int CV_WIN = 16 * 184, CV_GLU = 4 * 64, CV_PW = 4 * 32, CV_WO = 8 * 32, CV_WOUT = 16 * 32, CV_GU = NE * 16 * 64, CV_DN = NE * 16 * 32;
constexpr int CV_LAYER = CV_WIN + CV_GLU + CV_PW + CV_WO + CV_WOUT + CV_GU + CV_DN;

__device__ __forceinline__ void convert_item(const Args& a, int it, LAS float* scr, int lane) {
    unsigned char* ws = a.ws;
    const int layer = it / CV_LAYER; int r = it - layer * CV_LAYER;
    if (r < CV_WIN) { const int kb = r / 184, nb = r % 184;
        transpose_item(a.in[I_WIN] + (size_t)layer * D * INW, D, INW, (bf16*)(ws + WS_WIN) + (size_t)layer * INW * D, nb * 32, nb * 32, kb * 64, scr, lane); return; }
    r -= CV_WIN;
    if (r < CV_GLU) { const int kb = r / 64, nb = r % 64;
        transpose_item(a.in[I_GLUW] + (size_t)layer * 256 * 2048, 256, 2048, (bf16*)(ws + WS_WGLU) + (size_t)layer * 2048 * 256, nb * 32, ilv128(nb * 32, 1024), kb * 64, scr, lane); return; }
    r -= CV_GLU;
    if (r < CV_PW) { const int kb = r / 32, nb = r % 32;
        transpose_item(a.in[I_PWW] + (size_t)layer * 256 * 1024, 256, 1024, (bf16*)(ws + WS_WPW) + (size_t)layer * 1024 * 256, nb * 32, nb * 32, kb * 64, scr, lane); return; }
    r -= CV_PW;
    if (r < CV_WO) { const int kb = r / 32, nb = r % 32;
        transpose_item(a.in[I_WO] + (size_t)layer * 512 * 1024, 512, 1024, (bf16*)(ws + WS_WO) + (size_t)layer * 1024 * 512, nb * 32, nb * 32, kb * 64, scr, lane); return; }
    r -= CV_WO;
    if (r < CV_WOUT) { const int kb = r / 32, nb = r % 32;
        transpose_item(a.in[I_WOUT] + (size_t)layer * 1024 * 1024, 1024, 1024, (bf16*)(ws + WS_WOUT) + (size_t)layer * 1024 * 1024, nb * 32, nb * 32, kb * 64, scr, lane); return; }
    r -= CV_WOUT;
    if (r < CV_GU) { const int e = r >> 10, rr = r & 1023, kb = rr >> 6, nb = rr & 63; const size_t le = (size_t)layer * NE + e;
        transpose_item(a.in[I_GUW] + le * 1024 * 2048, 1024, 2048, (bf16*)(ws + WS_WGU) + le * 2048 * 1024, nb * 32, ilv128(nb * 32, 1024), kb * 64, scr, lane); return; }
    r -= CV_GU;
    { const int e = r >> 9, rr = r & 511, kb = rr >> 5, nb = rr & 31; const size_t le = (size_t)layer * NE + e;
        transpose_item(a.in[I_DW] + le * 1024 * 1024, 1024, 1024, (bf16*)(ws + WS_WD) + le * 1024 * 1024, nb * 32, nb * 32, kb * 64, scr, lane); }
}

__device__ __forceinline__ void ssm_build(const Args& a, int layer, int g, LAS unsigned char* lds, int tid) {
    LAS f32x2* pw = (LAS f32x2*)lds;
    LAS f32x2* Bb = (LAS f32x2*)(lds + 33792);
    LAS f32x2* Cm = (LAS f32x2*)(lds + 50176);
    LAS float* Kt = (LAS float*)(lds + 66560);
    const float* lam_re = a.in[I_LRE]; const float* lam_im = a.in[I_LIM]; const float* log_dt = a.in[I_LDT];
    __syncthreads();
    for (int idx = tid; idx < 2 * 33 * 64; idx += NTHR) { const int dir = idx / (33 * 64), rem = idx % (33 * 64), t = rem >> 6, p = rem & 63;
        const int pi = ((layer * 2 + dir) * 16 + g) * 64 + p;
        const float lr = fminf(lam_re[pi], -1e-4f), li = lam_im[pi], dt = expf(log_dt[(layer * 2 + dir) * 16 + g]);
        const float mag = expf(lr * dt * (float)t); float sn, cs; sincosf(li * dt * (float)t, &sn, &cs);
        pw[idx] = (f32x2){mag * cs, mag * sn}; }
    __syncthreads();
    for (int idx = tid; idx < 2048; idx += NTHR) { const int dir = idx >> 10;
        { const int p = (idx >> 4) & 63, m = idx & 15; const int pi = ((layer * 2 + dir) * 16 + g) * 64 + p;
          const float lr = fminf(lam_re[pi], -1e-4f), li = lam_im[pi]; const f32x2 lb = pw[(dir * 33 + 1) * 64 + p];
          const float nr = lb.x - 1.f, ni = lb.y, den = lr * lr + li * li, cr = (nr * lr + ni * li) / den, ci = (ni * lr - nr * li) / den;
          const float br = a.in[I_BRE][(size_t)pi * 16 + m], bi = a.in[I_BIM][(size_t)pi * 16 + m];
          Bb[idx] = (f32x2){cr * br - ci * bi, cr * bi + ci * br}; }
        { const int m = (idx >> 6) & 15, p = idx & 63; const size_t ci = ((size_t)((layer * 2 + dir) * 16 + g) * 16 + m) * 64 + p;
          Cm[idx] = (f32x2){a.in[I_CRE][ci], a.in[I_CIM][ci]}; } }
    __syncthreads();
    for (int idx = tid; idx < 2 * 32 * 256; idx += NTHR) { const int dir = idx >> 13, t = (idx >> 8) & 31, m = (idx >> 4) & 15, mp = idx & 15; float s = 0.f;
        for (int p = 0; p < 64; ++p) { const f32x2 c = Cm[(dir * 16 + m) * 64 + p], w = pw[(dir * 33 + t) * 64 + p], bb = Bb[(dir * 64 + p) * 16 + mp];
            s += (c.x * w.x - c.y * w.y) * bb.x - (c.x * w.y + c.y * w.x) * bb.y; }
        Kt[idx] = s; }
    __syncthreads();
    bf16* W1 = (bf16*)(a.ws + WS_SW1) + (size_t)(layer * 16 + g) * 768 * 512;
    for (int ch = tid; ch < 768 * 64; ch += NTHR) { const int n = ch >> 6, k8 = (ch & 63) << 3, j = k8 >> 4, mp0 = k8 & 15; float v[8];
        if (n < 512) { const int i = n >> 4, m = n & 15; const float dsk = a.in[I_SD][layer * 256 + g * 16 + m];
#pragma unroll
            for (int q = 0; q < 8; ++q) { const int mp = mp0 + q; float x = 0.f;
                if (j <= i) x += Kt[((i - j) * 16 + m) * 16 + mp];
                if (j >= i) x += Kt[((32 + (j - i)) * 16 + m) * 16 + mp];
                if (j == i && m == mp) x += dsk;
                v[q] = x; } }
        else { const int q_ = n - 512, dir = q_ >> 7, part = (q_ >> 6) & 1, p = q_ & 63, tp = dir ? j : 31 - j; const f32x2 w = pw[(dir * 33 + tp) * 64 + p];
#pragma unroll
            for (int q = 0; q < 8; ++q) { const f32x2 bb = Bb[(dir * 64 + p) * 16 + mp0 + q]; v[q] = part ? (w.x * bb.y + w.y * bb.x) : (w.x * bb.x - w.y * bb.y); } }
        *(GAS v4u*)(W1 + (size_t)n * 512 + k8) = pack8(v); }
    bf16* W2 = (bf16*)(a.ws + WS_SW2) + (size_t)(layer * 16 + g) * 512 * 256;
    for (int ch = tid; ch < 512 * 32; ch += NTHR) { const int n = ch >> 5, k8 = (ch & 31) << 3, i = n >> 4, m = n & 15, dir = k8 >> 7, part = (k8 >> 6) & 1, p0 = k8 & 63, tp = dir ? 32 - i : i + 1; float v[8];
#pragma unroll
        for (int q = 0; q < 8; ++q) { const f32x2 c = Cm[(dir * 16 + m) * 64 + p0 + q], w = pw[(dir * 33 + tp) * 64 + p0 + q];
            v[q] = part ? -(c.x * w.y + c.y * w.x) : (c.x * w.x - c.y * w.y); }
        *(GAS v4u*)(W2 + (size_t)n * 256 + k8) = pack8(v); }
    if (tid < 128) { const int dir = tid >> 6, p = tid & 63; const f32x2 w = pw[(dir * 33 + 32) * 64 + p];
        float* lc = (float*)(a.ws + WS_LAMC) + ((size_t)((layer * 2 + dir) * 16 + g) * 64 + p) * 2; lc[0] = w.x; lc[1] = w.y; }
    __syncthreads();
}

__device__ __forceinline__ void row_norm_mod(f32x4 (&v)[4], const float* g, const float* shift, const float* scale, int lane) {
    float s = 0.f;
#pragma unroll
    for (int j = 0; j < 4; ++j) s += (v[j].x * v[j].x + v[j].y * v[j].y) + (v[j].z * v[j].z + v[j].w * v[j].w);
    const float r = rsqrtf(wave_sum(s) * (1.f / D) + EPS);
#pragma unroll
    for (int j = 0; j < 4; ++j) { const f32x4 gg = *(const GAS f32x4*)(g + 4 * lane + 256 * j), sh = *(const GAS f32x4*)(shift + 4 * lane + 256 * j), sc = *(const GAS f32x4*)(scale + 4 * lane + 256 * j);
        v[j] = v[j] * r * gg * (1.f + sc) + sh; }
}
__device__ __forceinline__ void store_row_bf16(bf16* orow, const f32x4 (&v)[4], int lane) {
#pragma unroll
    for (int j = 0; j < 4; ++j) { v2u w; w.x = pk2(v[j].x, v[j].y); w.y = pk2(v[j].z, v[j].w); *(GAS v2u*)(orow + 4 * lane + 256 * j) = w; }
}

__device__ __forceinline__ void p0_prologue(const Args& a, LAS unsigned char* lds, int tid, int lane, int wave, int blk, int G) {
    LAS float* sT = (LAS float*)(lds + 69632);
    LAS float* red = (LAS float*)(lds + 106496);
    for (int i = tid; i < 9 * 1024; i += NTHR) { const float v = i < 8192 ? a.in[I_C][i] : a.in[I_CCTX][i - 8192]; sT[i] = silu_(v); }
    __syncthreads();
    float* mod = (float*)(a.ws + WS_MOD);
    for (int item = blk; item < DEPTH * 96; item += G) { const int layer = item / 96, cb = item % 96, col = cb * 64 + lane, k0 = wave * 128;
        const float* wp = a.in[I_ADAW] + ((size_t)layer * 1024 + k0) * 6144 + col;
        float acc[9];
#pragma unroll
        for (int r = 0; r < 9; ++r) acc[r] = 0.f;
#pragma unroll 8
        for (int kk = 0; kk < 128; ++kk) { const float w = wp[(size_t)kk * 6144];
#pragma unroll
            for (int r = 0; r < 9; ++r) acc[r] += sT[r * 1024 + k0 + kk] * w; }
#pragma unroll
        for (int r = 0; r < 9; ++r) red[(wave * 9 + r) * 64 + lane] = acc[r];
        __syncthreads();
        for (int o = tid; o < 9 * 64; o += NTHR) { const int r = o >> 6, l = o & 63; float s = 0.f;
#pragma unroll
            for (int w = 0; w < 8; ++w) s += red[(w * 9 + r) * 64 + l];
            mod[(size_t)(layer * 9 + r) * 6144 + cb * 64 + l] = s + a.in[I_ADAB][layer * 6144 + cb * 64 + l]; }
        __syncthreads();
    }
    if (blk >= G - 64) { const int u = blk - (G - 64); ssm_build(a, u >> 4, u & 15, lds, tid); }
    __syncthreads();
    LAS float* scr = (LAS float*)(lds + wave * 8448);
    const int gw = blk * NWAVES + wave, NGW = G * NWAVES;
    for (int it = gw; it < DEPTH * CV_LAYER; it += NGW) convert_item(a, it, scr, lane);
}

__device__ __forceinline__ void p0b_norm(const Args& a, int lane, int wave, int blk, int G) {
    float* xres = (float*)(a.ws + WS_X); bf16* H = (bf16*)(a.ws + WS_H); const float* mod = (const float*)(a.ws + WS_MOD);
    for (int row = blk * NWAVES + wave; row < T; row += G * NWAVES) {
        const float* src = row < TCTX ? a.in[I_CTX] + (size_t)row * D : a.in[I_X] + (size_t)(row - TCTX) * D;
        f32x4 v[4];
#pragma unroll
        for (int j = 0; j < 4; ++j) { v[j] = *(const GAS f32x4*)(src + 4 * lane + 256 * j); *(GAS f32x4*)(xres + (size_t)row * D + 4 * lane + 256 * j) = v[j]; }
        const float* mr = mod + (size_t)(0 * 9 + modrow(row)) * 6144;
        row_norm_mod(v, a.in[I_N1G], mr, mr + 1024, lane);
        store_row_bf16(H + (size_t)row * D, v, lane);
    }
}

typedef pg8::Unit Unit;
#define EPI_ROWS(ai, m) (u.pm * 256 + wr * 64 + fr + (ai) * 128 + (m) * 16)

struct EpiZ {
    static constexpr bool PERM = true, AFTER_DRAIN = false;
    bf16* O; int ldc;
    __device__ __forceinline__ void operator()(const f32x4 (&acc)[2][2][4][2], const Unit& u, int wr, int wc, int fr, int fq) const {
        const int col0 = u.pn * 256 + wc * 32 + 8 * fq;
#pragma unroll
        for (int ai = 0; ai < 2; ++ai)
#pragma unroll
            for (int m = 0; m < 4; ++m) { bf16* rowp = O + (size_t)EPI_ROWS(ai, m) * ldc + col0;
#pragma unroll
                for (int bj = 0; bj < 2; ++bj) { const f32x4 v0 = acc[ai][bj][m][0], v1 = acc[ai][bj][m][1]; v4u w; w.x = pk2(v0[0], v0[1]); w.y = pk2(v0[2], v0[3]); w.z = pk2(v1[0], v1[1]); w.w = pk2(v1[2], v1[3]);
                    *(GAS v4u*)(rowp + bj * 128) = w; } }
    }
};
struct EpiGlu {
    static constexpr bool PERM = true, AFTER_DRAIN = false;
    bf16* O; const bf16* Z; const float* bias;
    __device__ __forceinline__ void operator()(const f32x4 (&acc)[2][2][4][2], const Unit& u, int wr, int wc, int fr, int fq) const {
        const int colo = u.pn * 128 + wc * 32 + 8 * fq;
        v4u gz[8];
#pragma unroll
        for (int g8 = 0; g8 < 8; ++g8) gz[g8] = *(const GAS v4u*)(Z + (size_t)EPI_ROWS(g8 >> 2, g8 & 3) * INW + ZGS + colo);
        float ba[8], bg[8];
#pragma unroll
        for (int q = 0; q < 8; ++q) { ba[q] = bias[colo + q]; bg[q] = bias[1024 + colo + q]; }
#pragma unroll
        for (int g8 = 0; g8 < 8; ++g8) { const int ai = g8 >> 2, m = g8 & 3; const size_t row = EPI_ROWS(ai, m);
            float gs[8]; unpack8(gz[g8], gs); float o[8];
#pragma unroll
            for (int q = 0; q < 8; ++q) { const float av = acc[ai][0][m][q >> 2][q & 3] + ba[q], gv = acc[ai][1][m][q >> 2][q & 3] + bg[q]; o[q] = av * sigm(gv) * sigm(gs[q]); }
            *(GAS v4u*)(O + row * D + colo) = pack8(o); }
    }
};
struct EpiPw {
    static constexpr bool PERM = true, AFTER_DRAIN = false;
    bf16* O; const bf16* Z; const float* bias;
    __device__ __forceinline__ void operator()(const f32x4 (&acc)[2][2][4][2], const Unit& u, int wr, int wc, int fr, int fq) const {
#pragma unroll
        for (int bj = 0; bj < 2; ++bj) { const int col = u.pn * 256 + bj * 128 + wc * 32 + 8 * fq;
            v4u gz[8];
#pragma unroll
            for (int g8 = 0; g8 < 8; ++g8) gz[g8] = *(const GAS v4u*)(Z + (size_t)EPI_ROWS(g8 >> 2, g8 & 3) * INW + ZGC + col);
            float bb[8];
#pragma unroll
            for (int q = 0; q < 8; ++q) bb[q] = bias[col + q];
#pragma unroll
            for (int g8 = 0; g8 < 8; ++g8) { const int ai = g8 >> 2, m = g8 & 3; const size_t row = EPI_ROWS(ai, m);
                float gc[8]; unpack8(gz[g8], gc); float o[8];
#pragma unroll
                for (int q = 0; q < 8; ++q) o[q] = (acc[ai][bj][m][q >> 2][q & 3] + bb[q]) * sigm(gc[q]);
                *(GAS v4u*)(O + row * D + col) = pack8(o); }
            asm volatile("" ::: "memory"); }
    }
};
struct EpiWo {
    static constexpr bool PERM = true, AFTER_DRAIN = false;
    const bf16* M1; const bf16* M2; const bf16* Z; bf16* M3;
    __device__ __forceinline__ void operator()(const f32x4 (&acc)[2][2][4][2], const Unit& u, int wr, int wc, int fr, int fq) const {
#pragma unroll
        for (int bj = 0; bj < 2; ++bj) { const int col = u.pn * 256 + bj * 128 + wc * 32 + 8 * fq;
#pragma unroll
            for (int ai = 0; ai < 2; ++ai) { v4u gz[4], z1[4], z2[4];
#pragma unroll
                for (int m = 0; m < 4; ++m) { const size_t row = EPI_ROWS(ai, m); gz[m] = *(const GAS v4u*)(Z + row * INW + ZGR + col); z1[m] = *(const GAS v4u*)(M1 + row * D + col); z2[m] = *(const GAS v4u*)(M2 + row * D + col); }
#pragma unroll
                for (int m = 0; m < 4; ++m) { const size_t row = EPI_ROWS(ai, m);
                    float gr[8], a1[8], a2[8]; unpack8(gz[m], gr); unpack8(z1[m], a1); unpack8(z2[m], a2); float o[8];
#pragma unroll
                    for (int q = 0; q < 8; ++q) o[q] = acc[ai][bj][m][q >> 2][q & 3] * sigm(gr[q]) + a1[q] + a2[q];
                    *(GAS v4u*)(M3 + row * D + col) = pack8(o); }
                asm volatile("" ::: "memory"); } }
    }
};
struct EpiOut {
    static constexpr bool PERM = true, AFTER_DRAIN = false;
    const float* X; float* XO; const float* modl;
    __device__ __forceinline__ void operator()(const f32x4 (&acc)[2][2][4][2], const Unit& u, int wr, int wc, int fr, int fq) const {
        const int mr = u.pm < 8 ? 8 : (u.pm - 8) >> 3; const float* gate = modl + (size_t)mr * 6144 + 2048;
#pragma unroll
        for (int bj = 0; bj < 2; ++bj) { const int col = u.pn * 256 + bj * 128 + wc * 32 + 8 * fq;
            const f32x4 g0 = *(const GAS f32x4*)(gate + col), g1 = *(const GAS f32x4*)(gate + col + 4);
#pragma unroll
            for (int ai = 0; ai < 2; ++ai) { f32x4 x0[4], x1[4];
#pragma unroll
                for (int m = 0; m < 4; ++m) { const float* xp = X + (size_t)EPI_ROWS(ai, m) * D + col; x0[m] = *(const GAS f32x4*)xp; x1[m] = *(const GAS f32x4*)(xp + 4); }
#pragma unroll
                for (int m = 0; m < 4; ++m) { float* xp = XO + (size_t)EPI_ROWS(ai, m) * D + col;
                    *(GAS f32x4*)xp = x0[m] + g0 * acc[ai][bj][m][0]; *(GAS f32x4*)(xp + 4) = x1[m] + g1 * acc[ai][bj][m][1]; }
                asm volatile("" ::: "memory"); } }
    }
};
struct EpiGu {
    static constexpr bool PERM = true, AFTER_DRAIN = false;
    bf16* O; const float* bias;
    __device__ __forceinline__ void operator()(const f32x4 (&acc)[2][2][4][2], const Unit& u, int wr, int wc, int fr, int fq) const {
        const int e = u.pn >> 3, colo = (u.pn & 7) * 128 + wc * 32 + 8 * fq; const float* be = bias + (size_t)e * 2048;
        float bgt[8], bup[8];
#pragma unroll
        for (int q = 0; q < 8; ++q) { bgt[q] = be[colo + q]; bup[q] = be[1024 + colo + q]; }
#pragma unroll
        for (int ai = 0; ai < 2; ++ai)
#pragma unroll
            for (int m = 0; m < 4; ++m) { const size_t row = EPI_ROWS(ai, m); float o[8];
#pragma unroll
                for (int q = 0; q < 8; ++q) { const float gt = fminf(acc[ai][0][m][q >> 2][q & 3] + bgt[q], 7.f), up = fminf(fmaxf(acc[ai][1][m][q >> 2][q & 3] + bup[q], -7.f), 7.f);
                    o[q] = (up + 1.f) * gt * sigm(gt * 1.702f); }
                *(GAS v4u*)(O + row * D + colo) = pack8(o); asm volatile("" ::: "memory"); }
    }
};
struct EpiDown {
    static constexpr bool PERM = true, AFTER_DRAIN = false;
    bf16* O; const float* bias;
    __device__ __forceinline__ void operator()(const f32x4 (&acc)[2][2][4][2], const Unit& u, int wr, int wc, int fr, int fq) const {
        const int e = u.pn >> 2; const float* be = bias + (size_t)e * 1024;
#pragma unroll
        for (int bj = 0; bj < 2; ++bj) { const int col = (u.pn & 3) * 256 + bj * 128 + wc * 32 + 8 * fq; float bb[8];
#pragma unroll
            for (int q = 0; q < 8; ++q) bb[q] = be[col + q];
#pragma unroll
            for (int ai = 0; ai < 2; ++ai)
#pragma unroll
                for (int m = 0; m < 4; ++m) { const size_t row = EPI_ROWS(ai, m); float o[8];
#pragma unroll
                    for (int q = 0; q < 8; ++q) o[q] = acc[ai][bj][m][q >> 2][q & 3] + bb[q];
                    *(GAS v4u*)(O + row * D + col) = pack8(o); asm volatile("" ::: "memory"); } }
    }
};
struct MoeOrder {
    const int* info; int NC, nunits, G, c;
    __device__ __forceinline__ void init(const int* info_, int NC_, int G_, int c_) { info = info_; NC = NC_; G = G_; c = c_; nunits = info_[0] * NC_; }
    __device__ __forceinline__ bool next(int i, Unit& u) const {
        const int L = i * G + c; if (L >= nunits) return false;
        const int gi = L / (8 * NC), rem = L - gi * 8 * NC, pm = gi * 8 + (rem & 7), cn = rem >> 3;
        u.pm = pm; u.pn = info[64 + pm] * NC + cn; return true;
    }
    __device__ __forceinline__ void a_ready(const Unit&) const {}
    __device__ __forceinline__ void done(const Unit&) const {}
};

__device__ __forceinline__ void prep_unit(const Args& a, int u, LAS unsigned char* lds, int tid) {
    const int c = u % 18, h = (u / 18) & 3, b = u / 72;
    const int n0 = c * 128, rowbase = c < 2 ? b * CTXL + n0 : TCTX + b * LAT + (n0 - CTXL), i0 = n0 - CTXL; const bool lat = c >= 2;
    const bf16* Z = (const bf16*)(a.ws + WS_Z);
    bf16* Qr = (bf16*)(a.ws + WS_QR); bf16* Kr = (bf16*)(a.ws + WS_KR); bf16* Ktf = (bf16*)(a.ws + WS_KTF); bf16* Ktb = (bf16*)(a.ws + WS_KTB); bf16* Vt = (bf16*)(a.ws + WS_VT); bf16* Ug = (bf16*)(a.ws + WS_UG);
    LAS unsigned char* Kl = lds;
    LAS unsigned char* Vl = lds + 34816;
    LAS f32x2* ropeT = (LAS f32x2*)(lds + 69632);
    LAS float* zt = (LAS float*)(lds + 69632 + 16384);
    __syncthreads();
    for (int i = tid; i < 2048; i += NTHR) { const int pos = i >> 5, f = i & 31; const float inv = exp2f(-(float)f * (13.287712379549449f / 32.f)); float sn, cs; sincosf((float)pos * inv, &sn, &cs); ropeT[i] = (f32x2){cs, sn}; }
    if (tid < 256) { const int dir = tid >> 7, j = tid & 127; const float lg = lg2gamma(dir ? 3 - h : h); zt[tid] = exp2f(lg * (float)(dir ? j : 127 - j)); }
    __syncthreads();
    const size_t bh = (size_t)b * 4 + h;
    for (int t = tid; t < 1024; t += NTHR) { const int r = t >> 3, pc = t & 7, half = pc >> 2, f0 = (pc & 3) * 8, d1 = half * 64 + f0, d2 = d1 + 32;
        const bf16* zr = Z + (size_t)(rowbase + r) * INW;
        float q1[8], q2[8], k1[8], k2[8];
        unpack8(*(const GAS v4u*)(zr + ZQ + h * 128 + d1), q1); unpack8(*(const GAS v4u*)(zr + ZQ + h * 128 + d2), q2);
        unpack8(*(const GAS v4u*)(zr + ZK + h * 128 + d1), k1); unpack8(*(const GAS v4u*)(zr + ZK + h * 128 + d2), k2);
        const float ks = 0.08838834764831845f;
        if (lat) { const int i = i0 + r, pos = half ? (i & 63) : (i >> 6);
#pragma unroll
            for (int q = 0; q < 8; ++q) { const f32x2 cs = ropeT[pos * 32 + f0 + q];
                const float a1 = q1[q] * cs.x - q2[q] * cs.y, a2 = q1[q] * cs.y + q2[q] * cs.x; q1[q] = a1; q2[q] = a2;
                const float b1 = k1[q] * cs.x - k2[q] * cs.y, b2 = k1[q] * cs.y + k2[q] * cs.x; k1[q] = b1; k2[q] = b2; } }
#pragma unroll
        for (int q = 0; q < 8; ++q) { k1[q] *= ks; k2[q] *= ks; }
        const size_t o = (bh * SEQC + n0 + r) * 128;
        const v4u kw1 = pack8(k1), kw2 = pack8(k2);
        *(GAS v4u*)(Qr + o + d1) = pack8(q1); *(GAS v4u*)(Qr + o + d2) = pack8(q2);
        *(GAS v4u*)(Kr + o + d1) = kw1; *(GAS v4u*)(Kr + o + d2) = kw2;
        *(LAS v4u*)(Kl + r * 272 + d1 * 2) = kw1; *(LAS v4u*)(Kl + r * 272 + d2 * 2) = kw2; }
    for (int t = tid; t < 2048; t += NTHR) { const int r = t >> 4, cc = t & 15; *(LAS v4u*)(Vl + r * 272 + cc * 16) = *(const GAS v4u*)(Z + (size_t)(rowbase + r) * INW + ZV + h * 128 + cc * 8); }
    for (int t = tid; t < 1024; t += NTHR) { const int r = t >> 3, ch = t & 7, g = 4 * h + (ch >> 1), hf = ch & 1;
        *(GAS v4u*)(Ug + ((size_t)(g * NB + b) * SEQC + n0 + r) * 16 + hf * 8) = *(const GAS v4u*)(Z + (size_t)(rowbase + r) * INW + ZU + g * 16 + hf * 8); }
    __syncthreads();
    for (int t = tid; t < 2048; t += NTHR) { const int d = t & 127, j0 = (t >> 7) * 8; float kf[8], kb[8], vv[8];
#pragma unroll
        for (int q = 0; q < 8; ++q) { const float kv = bf2f(*(const LAS unsigned short*)(Kl + (j0 + q) * 272 + d * 2)); kf[q] = kv * zt[j0 + q]; kb[q] = kv * zt[128 + j0 + q];
            vv[q] = bf2f(*(const LAS unsigned short*)(Vl + (j0 + q) * 272 + d * 2)); }
        const size_t o = (bh * 128 + d) * SEQC + n0 + j0;
        *(GAS v4u*)(Ktf + o) = pack8(kf); *(GAS v4u*)(Ktb + o) = pack8(kb); *(GAS v4u*)(Vt + o) = pack8(vv); }
}

__device__ __forceinline__ void conv_unit(const Args& a, int layer, int u, LAS unsigned char* lds, int tid, int lane, int wave) {
    int seqrow, L, tile;
    if (u < 32) { seqrow = (u >> 2) * CTXL; L = CTXL; tile = u & 3; } else { const int v = u - 32; seqrow = TCTX + (v >> 5) * LAT; L = LAT; tile = v & 31; }
    const int t0 = tile * 64;
    const bf16* Z = (const bf16*)(a.ws + WS_Z); bf16* cact = (bf16*)(a.ws + WS_CACT);
    LAS unsigned short* hb = (LAS unsigned short*)lds;
    LAS float* cb = (LAS float*)(lds + 49152);
    __syncthreads();
    for (int idx = tid; idx < 94 * 32; idx += NTHR) { const int r = idx >> 5, ch = idx & 31, tp = t0 - 15 + r; v4u w = (v4u){0u, 0u, 0u, 0u};
        if (tp >= 0 && tp < L) { const bf16* zr = Z + (size_t)(seqrow + tp) * INW; float av[8], gv[8]; unpack8(*(const GAS v4u*)(zr + ZCA + ch * 8), av); unpack8(*(const GAS v4u*)(zr + ZCG + ch * 8), gv);
#pragma unroll
            for (int q = 0; q < 8; ++q) av[q] = av[q] * sigm(gv[q]);
            w = pack8(av); }
        *(LAS v4u*)(hb + r * 256 + ch * 8) = w; }
    __syncthreads();
    { const int c = tid & 255, hf = tid >> 8; float w[31];
#pragma unroll
        for (int k = 0; k < 31; ++k) w[k] = a.in[I_DWW][(size_t)(layer * 31 + k) * 256 + c];
        const float bias = a.in[I_DWB][layer * 256 + c];
        for (int tt = 0; tt < 8; ++tt) { const int r0 = hf * 32 + tt * 4; float acc[4] = {bias, bias, bias, bias};
#pragma unroll
            for (int k = 0; k < 34; ++k) { const float v = bf2f(hb[(r0 + k) * 256 + c]);
#pragma unroll
                for (int o = 0; o < 4; ++o) if (k - o >= 0 && k - o < 31) acc[o] += w[k - o] * v; }
#pragma unroll
            for (int o = 0; o < 4; ++o) cb[(r0 + o) * 256 + c] = acc[o]; } }
    __syncthreads();
    for (int q = 0; q < 8; ++q) { const int tl = wave * 8 + q; const f32x4 v = *(const LAS f32x4*)(cb + tl * 256 + 4 * lane);
        const float mean = wave_sum((v.x + v.y) + (v.z + v.w)) * (1.f / 256.f); const f32x4 dv = v - mean;
        const float var = wave_sum((dv.x * dv.x + dv.y * dv.y) + (dv.z * dv.z + dv.w * dv.w)) * (1.f / 256.f), rstd = rsqrtf(var + EPS);
        const f32x4 g = *(const GAS f32x4*)(a.in[I_LNG] + layer * 256 + 4 * lane), bb = *(const GAS f32x4*)(a.in[I_LNB] + layer * 256 + 4 * lane);
        const f32x4 y = dv * rstd * g + bb; v2u w; w.x = pk2(silu_(y.x), silu_(y.y)); w.y = pk2(silu_(y.z), silu_(y.w));
        *(GAS v2u*)(cact + (size_t)(seqrow + t0 + tl) * 256 + 4 * lane) = w; }
}

__device__ __forceinline__ void ssm_gemm1_unit(const Args& a, int layer, int u, LAS unsigned char* lds, int tid, int lane, int wave) {
    const int ct = u % 6, rt = (u / 6) % 9, g = u / 54;
    const bf16* A = (const bf16*)(a.ws + WS_UG) + ((size_t)g * SROWS + rt * 64) * 512;
    const bf16* B = (const bf16*)(a.ws + WS_SW1) + ((size_t)(layer * 16 + g) * 768 + ct * 128) * 512;
    LAS unsigned char* As = lds; LAS unsigned char* Bs = lds + 33792;
    const int wr = wave >> 1, wc = wave & 1, fr = lane & 15, fq = lane >> 4;
    f32x4 acc[4];
#pragma unroll
    for (int t = 0; t < 4; ++t) acc[t] = (f32x4){0.f, 0.f, 0.f, 0.f};
    for (int kh = 0; kh < 2; ++kh) {
        __syncthreads();
        bg_stage<64, 256>(As, A + kh * 256, 512, tid); bg_stage<128, 256>(Bs, B + kh * 256, 512, tid);
        __syncthreads();
        bg_mma<4, 256>(acc, As, Bs, 16 * wr, 64 * wc, fr, fq);
    }
    float* Y1 = (float*)(a.ws + WS_Y1); float* Zc = (float*)(a.ws + WS_ZC);
#pragma unroll
    for (int t = 0; t < 4; ++t)
#pragma unroll
        for (int r = 0; r < 4; ++r) { const int row = rt * 64 + 16 * wr + 4 * fq + r, col = ct * 128 + 64 * wc + 16 * t + fr;
            if (ct < 4) Y1[((size_t)g * SROWS + row) * 512 + col] = acc[t][r]; else Zc[((size_t)g * SROWS + row) * 256 + col - 512] = acc[t][r]; }
}
__device__ __forceinline__ void ssm_scan_unit(const Args& a, int layer, int u, int tid) {
    const int id = u * NTHR + tid, p = id & 63, g = (id >> 6) & 15, dir = (id >> 10) & 1, b = id >> 11;
    const float* lc = (const float*)(a.ws + WS_LAMC) + ((size_t)((layer * 2 + dir) * 16 + g) * 64 + p) * 2; const float lr = lc[0], li = lc[1];
    const float* Zc = (const float*)(a.ws + WS_ZC) + ((size_t)g * SROWS + b * NCH) * 256 + dir * 128 + p;
    bf16* Sin = (bf16*)(a.ws + WS_SIN) + ((size_t)g * SROWS + b * NCH) * 256 + dir * 128 + p;
    float sr = 0.f, si = 0.f;
    for (int s0 = 0; s0 < NCH; s0 += 8) { float zr[8], zi[8];
#pragma unroll
        for (int q = 0; q < 8; ++q) { const int st = s0 + q, c = dir == 0 ? st : (st < 8 ? 7 - st : 79 - st); zr[q] = Zc[(size_t)c * 256]; zi[q] = Zc[(size_t)c * 256 + 64]; }
#pragma unroll
        for (int q = 0; q < 8; ++q) { const int st = s0 + q, c = dir == 0 ? st : (st < 8 ? 7 - st : 79 - st);
            Sin[(size_t)c * 256] = (bf16)f2bf(sr); Sin[(size_t)c * 256 + 64] = (bf16)f2bf(si);
            const float nr = lr * sr - li * si + zr[q], ni = lr * si + li * sr + zi[q]; sr = nr; si = ni; } }
}
__device__ __forceinline__ void ssm_gemm2_unit(const Args& a, int layer, int u, LAS unsigned char* lds, int tid, int lane, int wave) {
    const int ct = u & 3, rt = (u >> 2) % 9, g = u / 36;
    const bf16* A = (const bf16*)(a.ws + WS_SIN) + ((size_t)g * SROWS + rt * 64) * 256;
    const bf16* B = (const bf16*)(a.ws + WS_SW2) + ((size_t)(layer * 16 + g) * 512 + ct * 128) * 256;
    LAS unsigned char* As = lds; LAS unsigned char* Bs = lds + 33792;
    const int wr = wave >> 1, wc = wave & 1, fr = lane & 15, fq = lane >> 4;
    f32x4 acc[4];
#pragma unroll
    for (int t = 0; t < 4; ++t) acc[t] = (f32x4){0.f, 0.f, 0.f, 0.f};
    __syncthreads();
    bg_stage<64, 256>(As, A, 256, tid); bg_stage<128, 256>(Bs, B, 256, tid);
    __syncthreads();
    bg_mma<4, 256>(acc, As, Bs, 16 * wr, 64 * wc, fr, fq);
    const float* Y1 = (const float*)(a.ws + WS_Y1); bf16* sact = (bf16*)(a.ws + WS_SACT);
#pragma unroll
    for (int t = 0; t < 4; ++t)
#pragma unroll
        for (int r = 0; r < 4; ++r) { const int R = rt * 64 + 16 * wr + 4 * fq + r, col = ct * 128 + 64 * wc + 16 * t + fr, b = R / NCH, ch = R % NCH, n = ch * 32 + (col >> 4);
            const float y = acc[t][r] + Y1[((size_t)g * SROWS + R) * 512 + col];
            sact[(size_t)tokrow(b, n) * 256 + g * 16 + (col & 15)] = (bf16)f2bf(gelu_tanh(y)); }
}

__device__ __forceinline__ void ret_state_unit(const Args& a, int u, LAS unsigned char* lds, int tid, int lane, int wave) {
    const int eb = u & 3, dir = (u >> 2) & 1, h = (u >> 3) & 3, b = u >> 5;
    const size_t bh = (size_t)b * 4 + h;
    const bf16* vt = (const bf16*)(a.ws + WS_VT) + (bh * 128 + eb * 32) * SEQC;
    const bf16* kz = (const bf16*)(a.ws + (dir ? WS_KTB : WS_KTF)) + bh * 128 * SEQC;
    bf16* Sp = (bf16*)(a.ws + WS_SPREV) + ((bh * 2 + dir) * 18) * (size_t)16384;
    const float gch = exp2f(128.f * lg2gamma(dir ? 3 - h : h));
    LAS unsigned char* As = lds; LAS unsigned char* Bs = lds + 8704;
    const int wr = wave & 1, wc = wave >> 1, fr = lane & 15, fq = lane >> 4;
    f32x4 acc[2] = {(f32x4){0.f, 0.f, 0.f, 0.f}, (f32x4){0.f, 0.f, 0.f, 0.f}};
    for (int st = 0; st < 18; ++st) { const int c = dir == 0 ? st : (st < 2 ? 1 - st : 19 - st);
#pragma unroll
        for (int t = 0; t < 2; ++t)
#pragma unroll
            for (int r = 0; r < 4; ++r) Sp[(size_t)c * 16384 + (eb * 32 + 16 * wr + 4 * fq + r) * 128 + 32 * wc + 16 * t + fr] = (bf16)f2bf(acc[t][r]);
        if (st == 17) break;
        const int n0 = c * 128;
        __syncthreads();
        { const int r = tid >> 4, cc = tid & 15; *(LAS v4u*)(As + r * 272 + cc * 16) = *(const GAS v4u*)(vt + (size_t)r * SEQC + n0 + cc * 8); }
        bg_stage<128, 128>(Bs, kz + n0, SEQC, tid);
        __syncthreads();
        acc[0] = acc[0] * gch; acc[1] = acc[1] * gch;
        bg_mma<2, 128>(acc, As, Bs, 16 * wr, 32 * wc, fr, fq);
    }
}
__device__ __forceinline__ void ret_out_unit(const Args& a, int u, LAS unsigned char* lds, int tid, int lane, int wave) {
    const int c = u % 18, h = (u / 18) & 3, b = u / 72;
    const int n0 = c * 128, rowbase = c < 2 ? b * CTXL + n0 : TCTX + b * LAT + (n0 - CTXL);
    const size_t bh = (size_t)b * 4 + h;
    const bf16* Qg = (const bf16*)(a.ws + WS_QR) + (bh * SEQC + n0) * 128;
    const bf16* Kg = (const bf16*)(a.ws + WS_KR) + (bh * SEQC + n0) * 128;
    const bf16* Vg = (const bf16*)(a.ws + WS_VT) + bh * 128 * SEQC + n0;
    const bf16* Sf = (const bf16*)(a.ws + WS_SPREV) + ((bh * 2 + 0) * 18 + c) * (size_t)16384;
    const bf16* Sb = (const bf16*)(a.ws + WS_SPREV) + ((bh * 2 + 1) * 18 + c) * (size_t)16384;
    LAS unsigned char* Qs = lds; LAS unsigned char* Bs = lds + 34816; LAS unsigned char* Ps = lds + 69632; LAS float* dtab = (LAS float*)(lds + 104448);
    const float lgf = lg2gamma(h), lgb = lg2gamma(3 - h);
    const int fr = lane & 15, fq = lane >> 4, ib = 16 * wave + 4 * fq;
    __syncthreads();
    if (tid < 255) { const int dl = tid - 127; dtab[tid] = dl > 0 ? exp2f(lgf * (float)dl) : (dl < 0 ? exp2f(lgb * (float)(-dl)) : 2.f); }
    bg_stage<128, 128>(Qs, Qg, 128, tid); bg_stage<128, 128>(Bs, Sf, 128, tid);
    __syncthreads();
    f32x4 o[8], s[8];
#pragma unroll
    for (int t = 0; t < 8; ++t) o[t] = (f32x4){0.f, 0.f, 0.f, 0.f};
    bg_mma<8, 128>(o, Qs, Bs, 16 * wave, 0, fr, fq);
    { f32x4 df;
#pragma unroll
      for (int r = 0; r < 4; ++r) df[r] = exp2f(lgf * (float)(ib + r + 1));
#pragma unroll
      for (int t = 0; t < 8; ++t) o[t] = o[t] * df; }
    __syncthreads();
    bg_stage<128, 128>(Bs, Sb, 128, tid);
    __syncthreads();
#pragma unroll
    for (int t = 0; t < 8; ++t) s[t] = (f32x4){0.f, 0.f, 0.f, 0.f};
    bg_mma<8, 128>(s, Qs, Bs, 16 * wave, 0, fr, fq);
    { f32x4 db;
#pragma unroll
      for (int r = 0; r < 4; ++r) db[r] = exp2f(lgb * (float)(128 - ib - r));
#pragma unroll
      for (int t = 0; t < 8; ++t) o[t] = o[t] + s[t] * db; }
    __syncthreads();
    bg_stage<128, 128>(Bs, Kg, 128, tid);
    __syncthreads();
#pragma unroll
    for (int t = 0; t < 8; ++t) s[t] = (f32x4){0.f, 0.f, 0.f, 0.f};
    bg_mma<8, 128>(s, Qs, Bs, 16 * wave, 0, fr, fq);
#pragma unroll
    for (int t = 0; t < 8; ++t)
#pragma unroll
        for (int r = 0; r < 4; ++r) { const int i = ib + r, j = 16 * t + fr; *(LAS unsigned short*)(Ps + i * 272 + j * 2) = (unsigned short)f2bf(s[t][r] * dtab[i - j + 127]); }
    __syncthreads();
    bg_stage<128, 128>(Bs, Vg, SEQC, tid);
    __syncthreads();
    bg_mma<8, 128>(o, Ps, Bs, 16 * wave, 0, fr, fq);
    const bf16* Z = (const bf16*)(a.ws + WS_Z); bf16* ract = (bf16*)(a.ws + WS_RACT);
#pragma unroll
    for (int r = 0; r < 4; ++r) { float ss = 0.f;
#pragma unroll
        for (int t = 0; t < 8; ++t) ss += o[t][r] * o[t][r];
        ss += __shfl_xor(ss, 1); ss += __shfl_xor(ss, 2); ss += __shfl_xor(ss, 4); ss += __shfl_xor(ss, 8);
        const float rinv = rsqrtf(ss * (1.f / 128.f) + EPS); const size_t row = rowbase + ib + r;
#pragma unroll
        for (int t = 0; t < 8; ++t) { const int e = 16 * t + fr; const float gt = bf2f(Z[row * INW + ZG + h * 128 + e]);
            ract[row * 512 + h * 128 + e] = (bf16)f2bf(o[t][r] * rinv * silu_(gt)); } }
}

__device__ __forceinline__ void moe_route(const Args& a, int layer, int row0, int RPB, LAS unsigned char* lds, int tid, int lane, int wave, int blk) {
    LAS float* hT = (LAS float*)lds;
    LAS float* part = (LAS float*)(lds + 65792);
    LAS float* lg = (LAS float*)(lds + 65792 + 16384);
    LAS int* histL = (LAS int*)(lds + 65792 + 16384 + 2048);
    const float* xres = (const float*)(a.ws + WS_X); bf16* H = (bf16*)(a.ws + WS_H);
    const float* modl = (const float*)(a.ws + WS_MOD) + (size_t)layer * 9 * 6144;
    const float* Wr = a.in[I_RW] + (size_t)layer * 1024 * 32; const float* br = a.in[I_RB] + layer * 32;
    int* ainfo = (int*)(a.ws + WS_AINFO); float* agate = (float*)(a.ws + WS_AGATE);
    __syncthreads();
    if (tid < 32) histL[tid] = 0;
    const int nsteps = (RPB + 15) >> 4, rbase = row0 + blk * RPB;
    float wb0[32], wb1[32];
#pragma unroll
    for (int ks = 0; ks < 32; ++ks) { const int k = wave * 128 + ks * 4 + (lane >> 4); wb0[ks] = Wr[(size_t)k * 32 + (lane & 15)]; wb1[ks] = Wr[(size_t)k * 32 + 16 + (lane & 15)]; }
    for (int st = 0; st < nsteps; ++st) {
        __syncthreads();
#pragma unroll
        for (int q = 0; q < 2; ++q) { const int lr = 2 * wave + q, rl = st * 16 + lr; const bool valid = rl < RPB; const int row = rbase + (valid ? rl : RPB - 1);
            f32x4 v[4];
#pragma unroll
            for (int j = 0; j < 4; ++j) v[j] = *(const GAS f32x4*)(xres + (size_t)row * D + 4 * lane + 256 * j);
            const float* mr = modl + (size_t)modrow(row) * 6144;
            row_norm_mod(v, a.in[I_N2G] + layer * D, mr + 3072, mr + 4096, lane);
            if (valid) store_row_bf16(H + (size_t)row * D, v, lane);
#pragma unroll
            for (int j = 0; j < 4; ++j) *(LAS f32x4*)(hT + lr * 1028 + 4 * lane + 256 * j) = v[j]; }
        __syncthreads();
        { f32x4 c0 = (f32x4){0.f, 0.f, 0.f, 0.f}, c1 = c0; const int rr = lane & 15, kq = lane >> 4;
#pragma unroll
          for (int ks = 0; ks < 32; ++ks) { const int k = wave * 128 + ks * 4 + kq; const float av = hT[rr * 1028 + k];
              c0 = __builtin_amdgcn_mfma_f32_16x16x4f32(av, wb0[ks], c0, 0, 0, 0); c1 = __builtin_amdgcn_mfma_f32_16x16x4f32(av, wb1[ks], c1, 0, 0, 0); }
#pragma unroll
          for (int r = 0; r < 4; ++r) { part[(wave * 16 + 4 * kq + r) * 32 + rr] = c0[r]; part[(wave * 16 + 4 * kq + r) * 32 + 16 + rr] = c1[r]; } }
        __syncthreads();
        { const int r = tid >> 5, e = tid & 31; float s = br[e];
#pragma unroll
          for (int w = 0; w < 8; ++w) s += part[(w * 16 + r) * 32 + e];
          lg[r * 32 + e] = s; }
        __syncthreads();
        if (tid < 16 && st * 16 + tid < RPB) { const int row = rbase + st * 16 + tid;
            float v0 = -3.0e38f, v1 = -3.0e38f, v2 = -3.0e38f, v3 = -3.0e38f; int i0 = 0, i1 = 0, i2 = 0, i3 = 0;
            for (int e = 0; e < 32; ++e) { float x = lg[tid * 32 + e]; int xi = e;
                if (x > v0) { const float tv = v0; v0 = x; x = tv; const int ti = i0; i0 = xi; xi = ti; }
                if (x > v1) { const float tv = v1; v1 = x; x = tv; const int ti = i1; i1 = xi; xi = ti; }
                if (x > v2) { const float tv = v2; v2 = x; x = tv; const int ti = i2; i2 = xi; xi = ti; }
                if (x > v3) { v3 = x; i3 = xi; } }
            const float e1 = __expf(v1 - v0), e2 = __expf(v2 - v0), e3 = __expf(v3 - v0), inv = 1.f / (1.f + e1 + e2 + e3);
            const int r0 = __hip_atomic_fetch_add(histL + i0, 1, __ATOMIC_RELAXED, __HIP_MEMORY_SCOPE_WORKGROUP), r1 = __hip_atomic_fetch_add(histL + i1, 1, __ATOMIC_RELAXED, __HIP_MEMORY_SCOPE_WORKGROUP);
            const int r2 = __hip_atomic_fetch_add(histL + i2, 1, __ATOMIC_RELAXED, __HIP_MEMORY_SCOPE_WORKGROUP), r3 = __hip_atomic_fetch_add(histL + i3, 1, __ATOMIC_RELAXED, __HIP_MEMORY_SCOPE_WORKGROUP);
            ainfo[row * 4 + 0] = i0 | (r0 << 8); ainfo[row * 4 + 1] = i1 | (r1 << 8); ainfo[row * 4 + 2] = i2 | (r2 << 8); ainfo[row * 4 + 3] = i3 | (r3 << 8);
            agate[row * 4 + 0] = inv; agate[row * 4 + 1] = e1 * inv; agate[row * 4 + 2] = e2 * inv; agate[row * 4 + 3] = e3 * inv; }
    }
    __syncthreads();
    if (tid < 32) ((int*)a.ws + CW_HIST)[blk * 32 + tid] = histL[tid];
}
__device__ __forceinline__ void moe_gather(const Args& a, int row0, int RPB, LAS unsigned char* lds, int tid, int lane, int wave, int blk, int G) {
    LAS int* ptot = (LAS int*)lds;
    LAS int* pbas = (LAS int*)(lds + 2048);
    LAS int* pbase = (LAS int*)(lds + 4096);
    LAS int* pstart = (LAS int*)(lds + 4096 + 128);
    const int* hist = (const int*)a.ws + CW_HIST;
    __syncthreads();
    { const int e = tid & 31, seg = tid >> 5; int tot = 0, bas = 0;
#pragma unroll
      for (int q = 0; q < 16; ++q) { const int bb = seg * 16 + q; const int v = bb < G ? hist[bb * 32 + e] : 0; tot += v; bas += bb < blk ? v : 0; }
      ptot[seg * 32 + e] = tot; pbas[seg * 32 + e] = bas; }
    __syncthreads();
    if (tid < 32) { int tot = 0, bas = 0;
#pragma unroll
        for (int s = 0; s < 16; ++s) { tot += ptot[s * 32 + tid]; bas += pbas[s * 32 + tid]; }
        ptot[tid] = (tot + 255) >> 8; pbas[tid] = bas; }
    __syncthreads();
    if (tid < 32) { int st = 0; for (int e = 0; e < tid; ++e) st += ptot[e]; pstart[tid] = st; pbase[tid] = st * 256 + pbas[tid]; if (tid == 31) pstart[32] = st + ptot[31]; }
    __syncthreads();
    if (blk == 0) { int* info = (int*)a.ws + CW_MOE; const int nt = pstart[32], ntp = (nt + 7) & ~7;
        if (tid == 0) info[0] = ntp;
        for (int t = tid; t < XB_TILES; t += NTHR) { int e = 0; if (t < nt) { for (int q = 1; q < 32; ++q) if (pstart[q] <= t) e = q; } info[64 + t] = e; } }
    const int* ainfo = (const int*)(a.ws + WS_AINFO); int* aslot = (int*)(a.ws + WS_ASLOT);
    const bf16* H = (const bf16*)(a.ws + WS_H); bf16* XB = (bf16*)(a.ws + WS_XB);
    const int rbase = row0 + blk * RPB;
    for (int pr = wave; pr < RPB * 4; pr += NWAVES) { const int row = rbase + (pr >> 2), k = pr & 3; const int inf = ainfo[row * 4 + k]; const int slot = pbase[inf & 255] + (inf >> 8);
        if (lane == 0) aslot[row * 4 + k] = slot;
        const v4u w0 = *(const GAS v4u*)(H + (size_t)row * D + lane * 8), w1 = *(const GAS v4u*)(H + (size_t)row * D + 512 + lane * 8);
        *(GAS v4u*)(XB + (size_t)slot * D + lane * 8) = w0; *(GAS v4u*)(XB + (size_t)slot * D + 512 + lane * 8) = w1; }
}
__device__ __forceinline__ void moe_combine(const Args& a, int layer, int row0, int lane, int wave, int blk, int G, bool dummy) {
    const float* xres = (const float*)(a.ws + WS_X); float* xw = (float*)(a.ws + (dummy ? WS_DUMMY : WS_X)); bf16* H = (bf16*)(a.ws + (dummy ? WS_DUMMY : WS_H)); float* outp = dummy ? (float*)(a.ws + WS_DUMMY) : a.out;
    const bf16* YB = (const bf16*)(a.ws + WS_YB);
    const float* mod = (const float*)(a.ws + WS_MOD);
    const int* aslot = (const int*)(a.ws + WS_ASLOT); const float* agate = (const float*)(a.ws + WS_AGATE);
    const bool last = layer == DEPTH - 1;
    const int stride = G * NWAVES;
    for (int rowa = row0 + blk * NWAVES + wave; rowa < T; rowa += 2 * stride) {
        const bool two = rowa + stride < T; const int rowb = two ? rowa + stride : rowa;
        int sl[2][4]; float gk[2][4];
#pragma unroll
        for (int k = 0; k < 4; ++k) { sl[0][k] = aslot[rowa * 4 + k]; gk[0][k] = agate[rowa * 4 + k]; sl[1][k] = aslot[rowb * 4 + k]; gk[1][k] = agate[rowb * 4 + k]; }
        v2u yv[2][4][4]; f32x4 xv[2][4];
#pragma unroll
        for (int p = 0; p < 2; ++p) {
#pragma unroll
            for (int k = 0; k < 4; ++k)
#pragma unroll
                for (int j = 0; j < 4; ++j) yv[p][k][j] = *(const GAS v2u*)(YB + (size_t)sl[p][k] * D + 4 * lane + 256 * j);
#pragma unroll
            for (int j = 0; j < 4; ++j) xv[p][j] = *(const GAS f32x4*)(xres + (size_t)(p ? rowb : rowa) * D + 4 * lane + 256 * j); }
#pragma unroll
        for (int p = 0; p < 2; ++p) { if (p == 1 && !two) break;
            const int row = p ? rowb : rowa; const int mrw = modrow(row); const float* ml = mod + (size_t)(layer * 9 + mrw) * 6144;
            f32x4 v[4];
#pragma unroll
            for (int j = 0; j < 4; ++j) { f32x4 acc = (f32x4){0.f, 0.f, 0.f, 0.f};
#pragma unroll
                for (int k = 0; k < 4; ++k) { const v2u w = yv[p][k][j]; acc += gk[p][k] * (f32x4){blo(w.x), bhi(w.x), blo(w.y), bhi(w.y)}; }
                const f32x4 g = *(const GAS f32x4*)(ml + 5120 + 4 * lane + 256 * j); v[j] = xv[p][j] + g * acc; }
            if (!last) {
#pragma unroll
                for (int j = 0; j < 4; ++j) *(GAS f32x4*)(xw + (size_t)row * D + 4 * lane + 256 * j) = v[j];
                const float* mn = mod + (size_t)((layer + 1) * 9 + mrw) * 6144;
                row_norm_mod(v, a.in[I_N1G] + (layer + 1) * D, mn, mn + 1024, lane);
                store_row_bf16(H + (size_t)row * D, v, lane);
            } else {
                float s = 0.f;
#pragma unroll
                for (int j = 0; j < 4; ++j) s += (v[j].x * v[j].x + v[j].y * v[j].y) + (v[j].z * v[j].z + v[j].w * v[j].w);
                const float r = rsqrtf(wave_sum(s) * (1.f / D) + EPS);
#pragma unroll
                for (int j = 0; j < 4; ++j) { const f32x4 g = *(const GAS f32x4*)(a.in[I_FG] + 4 * lane + 256 * j); *(GAS f32x4*)(outp + (size_t)(row - TCTX) * D + 4 * lane + 256 * j) = v[j] * r * g; }
            }
        }
    }
}

__device__ __forceinline__ void grid_sync(const XcdBarrier& b0) { XcdBarrier b = b0; unsigned x = __builtin_amdgcn_readfirstlane(b0.x); asm volatile("" : "+s"(x)); b.x = x; xcd_barrier(b); }
#define PHASE_ENV() int tid = tid0; asm volatile("" : "+v"(tid)); const int lane = tid & 63, wave = __builtin_amdgcn_readfirstlane(tid >> 6); \
    const __attribute__((address_space(4))) Args* ap_ = (const __attribute__((address_space(4))) Args*)__builtin_amdgcn_kernarg_segment_ptr(); asm volatile("" : "+s"(ap_)); \
    const Args& a = *(const Args*)ap_; unsigned char* ws = a.ws; int layer = layer0; asm volatile("" : "+s"(layer)); (void)lane; (void)wave; (void)layer; (void)ws;
#ifndef PROBE
#define PROBE 0
#endif
#define REP(k) for (int rep_ = 0; rep_ < ((PROBE == (k)) ? 2 : 1); ++rep_)
__global__ void __launch_bounds__(NTHR, 2) fwd_kernel(const Args a0) {
    extern __shared__ __attribute__((aligned(16))) unsigned char lds_raw[];
    LAS unsigned char* lds = (LAS unsigned char*)lds_raw;
    const int tid0 = threadIdx.x, blk = blockIdx.x, G = gridDim.x;
    volatile LAS unsigned* misc = (volatile LAS unsigned*)(lds + MISC_OFF);
    if (tid0 < 64) misc[tid0] = 0u;
    __syncthreads();
    XcdBarrier bar = xcd_barrier_post((unsigned*)a0.ws + CW_BAR, misc);
    int layer0 = 0;

    REP(1) { { PHASE_ENV(); p0_prologue(a, lds, tid, lane, wave, blk, G); }
    grid_sync(bar); }
    { PHASE_ENV(); p0b_norm(a, lane, wave, blk, G); }
    grid_sync(bar);

    for (layer0 = 0; layer0 < DEPTH; ++layer0) {
        REP(2) {
        { PHASE_ENV(); pg8::Gemm g{(const bf16*)(ws + WS_H), (const bf16*)(ws + WS_WIN) + (size_t)layer * INW * D, T, INW, D}; pg8::StaticOrder S; S.init(T, INW, G, blk);
          EpiZ E{(bf16*)(ws + WS_Z), INW};
          pg8::gemm_phase<EpiZ, pg8::StaticOrder, true, true>(lds, g, S, E, tid); }
        grid_sync(bar); }
        REP(3) {
        { PHASE_ENV(); for (int u = blk; u < 576; u += G) prep_unit(a, u, lds, tid); }
        { PHASE_ENV(); for (int u = blk; u < 288; u += G) conv_unit(a, layer, u, lds, tid, lane, wave); }
        grid_sync(bar);
        REP(11) {
        { PHASE_ENV(); for (int u = blk; u < 256; u += G) ret_state_unit(a, u, lds, tid, lane, wave); }
        { PHASE_ENV(); for (int u = blk; u < 864; u += G) ssm_gemm1_unit(a, layer, u, lds, tid, lane, wave); }
        grid_sync(bar); }
        REP(12) {
        { PHASE_ENV(); for (int u = blk; u < 32; u += G) ssm_scan_unit(a, layer, u, tid); }
        { PHASE_ENV(); for (int u = blk; u < 576; u += G) ret_out_unit(a, u, lds, tid, lane, wave); }
        grid_sync(bar); }
        { PHASE_ENV(); for (int u = blk; u < 576; u += G) ssm_gemm2_unit(a, layer, u, lds, tid, lane, wave); }
        grid_sync(bar); }
        REP(7) {
        { PHASE_ENV(); int kk_ = 256; asm volatile("" : "+s"(kk_)); pg8::Gemm g{(const bf16*)(ws + WS_SACT), (const bf16*)(ws + WS_WGLU) + (size_t)layer * 2048 * 256, T, 2048, kk_}; pg8::StaticOrder S; S.init(T, 2048, G, blk);
          EpiGlu E{(bf16*)(ws + WS_M1), (const bf16*)(ws + WS_Z), a.in[I_GLUB] + layer * 2048};
          pg8::gemm_phase<EpiGlu, pg8::StaticOrder, true, true>(lds, g, S, E, tid); }
        { PHASE_ENV(); int kk_ = 256; asm volatile("" : "+s"(kk_)); pg8::Gemm g{(const bf16*)(ws + WS_CACT), (const bf16*)(ws + WS_WPW) + (size_t)layer * 1024 * 256, T, 1024, kk_}; pg8::StaticOrder S; S.init(T, 1024, G, blk);
          EpiPw E{(bf16*)(ws + WS_M2), (const bf16*)(ws + WS_Z), a.in[I_PWB] + layer * 1024};
          pg8::gemm_phase<EpiPw, pg8::StaticOrder, true, true>(lds, g, S, E, tid); }
        grid_sync(bar); }
        REP(8) {
        { PHASE_ENV(); pg8::Gemm g{(const bf16*)(ws + WS_RACT), (const bf16*)(ws + WS_WO) + (size_t)layer * 1024 * 512, T, 1024, 512}; pg8::StaticOrder S; S.init(T, 1024, G, blk);
          EpiWo E{(const bf16*)(ws + WS_M1), (const bf16*)(ws + WS_M2), (const bf16*)(ws + WS_Z), (bf16*)(ws + WS_M3)};
          pg8::gemm_phase<EpiWo, pg8::StaticOrder, true, true>(lds, g, S, E, tid); }
        grid_sync(bar); }
        REP(9) {
        { PHASE_ENV(); pg8::Gemm g{(const bf16*)(ws + WS_M3), (const bf16*)(ws + WS_WOUT) + (size_t)layer * 1024 * 1024, T, 1024, 1024}; pg8::StaticOrder S; S.init(T, 1024, G, blk);
          EpiOut E{(float*)(ws + WS_X), (float*)(ws + (rep_ ? WS_DUMMY : WS_X)), (const float*)(ws + WS_MOD) + (size_t)layer * 9 * 6144};
          pg8::gemm_phase<EpiOut, pg8::StaticOrder, true, true>(lds, g, S, E, tid); }
        grid_sync(bar); }
        REP(4) {
        { PHASE_ENV(); const int row0 = layer == DEPTH - 1 ? TCTX : 0, RPB = (T - row0) / 256; moe_route(a, layer, row0, RPB, lds, tid, lane, wave, blk); }
        grid_sync(bar);
        { PHASE_ENV(); const int row0 = layer == DEPTH - 1 ? TCTX : 0, RPB = (T - row0) / 256; moe_gather(a, row0, RPB, lds, tid, lane, wave, blk, G); }
        grid_sync(bar); }
        REP(5) {
        { PHASE_ENV(); pg8::Gemm g{(const bf16*)(ws + WS_XB), (const bf16*)(ws + WS_WGU) + (size_t)layer * NE * 2048 * 1024, XB_ROWS, NE * 2048, D}; MoeOrder S; S.init((const int*)ws + CW_MOE, 8, G, blk);
          EpiGu E{(bf16*)(ws + WS_ACT), a.in[I_GUB] + (size_t)layer * NE * 2048};
          pg8::gemm_phase<EpiGu, MoeOrder, true, true>(lds, g, S, E, tid); }
        grid_sync(bar); }
        REP(6) {
        { PHASE_ENV(); pg8::Gemm g{(const bf16*)(ws + WS_ACT), (const bf16*)(ws + WS_WD) + (size_t)layer * NE * 1024 * 1024, XB_ROWS, NE * 1024, D}; MoeOrder S; S.init((const int*)ws + CW_MOE, 4, G, blk);
          EpiDown E{(bf16*)(ws + WS_YB), a.in[I_DB] + (size_t)layer * NE * 1024};
          pg8::gemm_phase<EpiDown, MoeOrder, true, true>(lds, g, S, E, tid); }
        grid_sync(bar); }
        REP(10) {
        { PHASE_ENV(); const int row0 = layer == DEPTH - 1 ? TCTX : 0; moe_combine(a, layer, row0, lane, wave, blk, G, rep_ != 0); }
        grid_sync(bar); }
    }
}

extern "C" void kernel_launch(void* const* d_in, const int* in_sizes, int n_in, void* d_out, int out_size, void* d_ws, size_t ws_size, hipStream_t stream) {
    static int grid = 0;
    if (grid == 0) {
        if (n_in != 34 || out_size != NB * LAT * D || ws_size < WS_END) { fprintf(stderr, "kernel_launch: unexpected shapes (n_in %d, out %d, ws %zu, need %zu); nothing launched\n", n_in, out_size, ws_size, (size_t)WS_END); grid = -1; return; }
        int dev = 0, cus = 0, per_cu = 0;
        if (hipGetDevice(&dev) != hipSuccess || hipDeviceGetAttribute(&cus, hipDeviceAttributeMultiprocessorCount, dev) != hipSuccess) { grid = -1; return; }
        if (hipFuncSetAttribute((const void*)fwd_kernel, hipFuncAttributeMaxDynamicSharedMemorySize, LDS_BYTES) != hipSuccess) { fprintf(stderr, "kernel_launch: hipFuncSetAttribute failed\n"); grid = -1; return; }
        if (hipOccupancyMaxActiveBlocksPerMultiprocessor(&per_cu, (const void*)fwd_kernel, NTHR, LDS_BYTES) != hipSuccess || per_cu < 1) fprintf(stderr, "kernel_launch: occupancy query reports %d\n", per_cu);
        (void)hipGetLastError();
        grid = cus < 256 ? cus : 256;
    }
    if (grid < 0) return;
    if (hipMemsetAsync((char*)d_ws + WS_CTL, 0, CTL_BYTES, stream) != hipSuccess) return;
    Args a{};
    for (int i = 0; i < 34; ++i) a.in[i] = (const float*)d_in[i];
    a.out = (float*)d_out; a.ws = (unsigned char*)d_ws;
    hipLaunchKernelGGL(fwd_kernel, dim3(grid), dim3(NTHR), LDS_BYTES, stream, a);
}
```
